# Optimizing an MI355X kernel written in HIP

```python
import math
import jax
import jax.numpy as jnp
from jax import lax
import numpy as np

D_MODEL = 2048
BATCH = 1
SEQ = 16384
DEPTH = 4

GRID_W = 64
CTX_LEN = 256
N_EVEN = (DEPTH + 1) // 2
N_ODD = DEPTH // 2

A_HEADS = 8
A_QK_DIM = 64
A_V_DIM = 2 * A_QK_DIM
A_QKV = A_HEADS * 2 * A_QK_DIM
B_HEADS = 8
B_HEAD_DIM = 128
B_QKV = B_HEADS * B_HEAD_DIM
WIN_R = 8
WIN_C = 16
S5_CH = 512
S5_GROUP = 16
S5_GROUPS = S5_CH // S5_GROUP
S5_STATE = 64
RET_HEADS = 12
RET_HEAD_DIM = 128
RET_WIDTH = RET_HEADS * RET_HEAD_DIM
RET_CHUNK = 128
EVEN_IN = 3 * A_QKV + 3 * B_QKV
EVEN_OUT = A_HEADS * A_V_DIM + B_QKV
ODD_IN = S5_CH + 4 * RET_WIDTH
ODD_OUT = S5_CH + RET_WIDTH
D_FF = -(-8 * D_MODEL // (3 * 256)) * 256

Q_BLOCK = 128
ROPE_BASE = 10000.0
EPS = 1e-6
NEG_INF = -1e30
F32 = jnp.float32

kernel_name = "hybrid_diffattn_natten_s5_retention_dit"


def rms_norm(x, w=None):
    xf = x.astype(F32)
    y = xf * lax.rsqrt(jnp.mean(xf * xf, axis=-1, keepdims=True) + EPS)
    if w is not None:
        y = y * w.astype(F32)
    return y.astype(x.dtype)


def modulate(h, shift, scale):
    return h * (1.0 + scale) + shift


def split_cols(t, sizes):
    outs, start = [], 0
    for s in sizes:
        outs.append(t[..., start:start + s])
        start += s
    return outs


def swiglu(h, w13, w2):
    a, b = jnp.split(h @ w13, 2, axis=-1)
    return (jax.nn.silu(a) * b) @ w2


def axial_rope_tables(n_tokens, dim):
    n_freq = dim // 4
    freq = ROPE_BASE ** (-jnp.arange(n_freq, dtype=F32) / n_freq)
    t = jnp.arange(n_tokens)
    row = (t // GRID_W).astype(F32)
    col = (t % GRID_W).astype(F32)
    ang = jnp.stack([row[:, None] * freq, col[:, None] * freq], axis=1)
    ang = jnp.broadcast_to(ang[:, :, None, :], (n_tokens, 2, 2, n_freq)).reshape(n_tokens, dim)
    return jnp.cos(ang), jnp.sin(ang)


def apply_axial_rope(x, cos, sin):
    shp = x.shape
    xr = x.reshape(shp[:-1] + (2, 2, shp[-1] // 4))
    rot = jnp.stack([-xr[..., 1, :], xr[..., 0, :]], axis=-2).reshape(shp)
    return (x * cos + rot * sin).astype(x.dtype)


def diff_attention(q1, q2, k1, k2, v, lam):
    b, h, nq, dqk = q1.shape
    nb = nq // Q_BLOCK
    scale = dqk ** -0.5

    def to_blocks(q):
        return jnp.moveaxis(q.reshape(b, h, nb, Q_BLOCK, dqk), 2, 0)

    def one_block(qs):
        qa, qb = qs
        s1 = jnp.einsum('bhqd,bhkd->bhqk', qa, k1).astype(F32) * scale
        s2 = jnp.einsum('bhqd,bhkd->bhqk', qb, k2).astype(F32) * scale
        p = jax.nn.softmax(s1, axis=-1) - lam * jax.nn.softmax(s2, axis=-1)
        return jnp.einsum('bhqk,bhkd->bhqd', p.astype(v.dtype), v)

    o = lax.map(one_block, (to_blocks(q1), to_blocks(q2)))
    return jnp.moveaxis(o, 0, 2).reshape(b, h, nq, v.shape[-1])


def softmax_attention(q, k, v):
    s = jnp.einsum('bhqd,bhkd->bhqk', q, k).astype(F32) * (q.shape[-1] ** -0.5)
    return jnp.einsum('bhqk,bhkd->bhqd', jax.nn.softmax(s, axis=-1).astype(v.dtype), v)


def neighborhood_attention(q, k, v, k_ctx, v_ctx, rpb):
    bsz, nh, n, dh = q.shape
    rows = n // GRID_W
    wr = min(WIN_R, rows)
    scale = dh ** -0.5
    qg = q.reshape(bsz, nh, rows, GRID_W, dh)
    kg = k.reshape(bsz, nh, rows, GRID_W, dh)
    vg = v.reshape(bsz, nh, rows, GRID_W, dh)
    r = jnp.arange(rows)
    r0 = jnp.clip(r - wr // 2, 0, rows - wr)
    ridx = r0[:, None] + jnp.arange(wr)[None, :]
    kw = kg[:, :, ridx].reshape(bsz, nh, rows, wr * GRID_W, dh)
    vw = vg[:, :, ridx].reshape(bsz, nh, rows, wr * GRID_W, dh)
    j = jnp.arange(GRID_W)
    c0 = jnp.clip(j - WIN_C // 2, 0, GRID_W - WIN_C)
    col_ok = (j[None, :] >= c0[:, None]) & (j[None, :] < c0[:, None] + WIN_C)
    col_ok = jnp.broadcast_to(col_ok[:, None, :], (GRID_W, wr, GRID_W)).reshape(GRID_W, wr * GRID_W)
    drow = ridx - r[:, None] + (WIN_R - 1)
    dcol = jnp.clip(j[None, :] - j[:, None] + (WIN_C - 1), 0, 2 * WIN_C - 2)
    bias = rpb.astype(F32)[:, drow][:, :, :, dcol]
    bias = bias.transpose(0, 1, 3, 2, 4).reshape(nh, rows, GRID_W, wr * GRID_W)
    s_loc = jnp.einsum('bhrqd,bhrkd->bhrqk', qg, kw).astype(F32) * scale + bias
    s_loc = jnp.where(col_ok, s_loc, NEG_INF)
    s_ctx = jnp.einsum('bhrqd,bhkd->bhrqk', qg, k_ctx).astype(F32) * scale
    p = jax.nn.softmax(jnp.concatenate([s_loc, s_ctx], axis=-1), axis=-1).astype(v.dtype)
    n_loc = wr * GRID_W
    o = (jnp.einsum('bhrqk,bhrkd->bhrqd', p[..., :n_loc], vw)
         + jnp.einsum('bhrqk,bhkd->bhrqd', p[..., n_loc:], v_ctx))
    return o.reshape(bsz, nh, n, dh)


def even_mixer(h, hc, w_in, w_out, lq1, lk1, lq2, lk2, subln_w, rpb, lambda_init,
               rope_cos, rope_sin, compute_ctx):
    sizes = [A_QKV] * 3 + [B_QKV] * 3
    qa, ka, va, qb, kb, vb = split_cols(h @ w_in, sizes)
    qac, kac, vac, qbc, kbc, vbc = split_cols(hc @ w_in, sizes)

    def a_qk(t):
        return t.reshape(t.shape[0], t.shape[1], A_HEADS, 2, A_QK_DIM).transpose(0, 2, 3, 1, 4)

    def heads(t, nh):
        return t.reshape(t.shape[0], t.shape[1], nh, -1).transpose(0, 2, 1, 3)

    def merge(o):
        return o.transpose(0, 2, 1, 3).reshape(o.shape[0], o.shape[2], -1)

    def a_out(o):
        return merge(rms_norm(o, subln_w) * (1.0 - lambda_init))

    lam = (jnp.exp(jnp.sum(lq1.astype(F32) * lk1.astype(F32)))
           - jnp.exp(jnp.sum(lq2.astype(F32) * lk2.astype(F32))) + lambda_init)
    q_a = apply_axial_rope(a_qk(qa), rope_cos, rope_sin)
    k_a = apply_axial_rope(a_qk(ka), rope_cos, rope_sin)
    q_ac, k_ac, v_ac = a_qk(qac), a_qk(kac), heads(vac, A_HEADS)
    k1 = jnp.concatenate([k_ac[:, :, 0], k_a[:, :, 0]], axis=2)
    k2 = jnp.concatenate([k_ac[:, :, 1], k_a[:, :, 1]], axis=2)
    v_all = jnp.concatenate([v_ac, heads(va, A_HEADS)], axis=2)
    o_a = a_out(diff_attention(q_a[:, :, 0], q_a[:, :, 1], k1, k2, v_all, lam))
    k_bc, v_bc = heads(kbc, B_HEADS), heads(vbc, B_HEADS)
    o_b = merge(neighborhood_attention(heads(qb, B_HEADS), heads(kb, B_HEADS), heads(vb, B_HEADS),
                                       k_bc, v_bc, rpb))
    y = jnp.concatenate([o_a, o_b], axis=-1).astype(h.dtype) @ w_out
    if not compute_ctx:
        return y, None
    o_ac = a_out(diff_attention(q_ac[:, :, 0], q_ac[:, :, 1], k_ac[:, :, 0], k_ac[:, :, 1], v_ac, lam))
    o_bc = merge(softmax_attention(heads(qbc, B_HEADS), k_bc, v_bc))
    yc = jnp.concatenate([o_ac, o_bc], axis=-1).astype(hc.dtype) @ w_out
    return y, yc


def s5_discretize(lam_re, lam_im, b_re, b_im, log_step):
    lr, li = lam_re.astype(F32), lam_im.astype(F32)
    dt = jnp.exp(log_step.astype(F32))[:, None]
    mag = jnp.exp(lr * dt)
    ar, ai = mag * jnp.cos(li * dt), mag * jnp.sin(li * dt)
    den = lr * lr + li * li
    nr, ni = ar - 1.0, ai
    fr = (nr * lr + ni * li) / den
    fi = (ni * lr - nr * li) / den
    br_, bi_ = b_re.astype(F32), b_im.astype(F32)
    bbr = fr[..., None] * br_ - fi[..., None] * bi_
    bbi = fr[..., None] * bi_ + fi[..., None] * br_
    return ar, ai, bbr, bbi


def _linear_recurrence_op(e1, e2):
    a1r, a1i, b1r, b1i = e1
    a2r, a2i, b2r, b2i = e2
    return (a1r * a2r - a1i * a2i, a1r * a2i + a1i * a2r,
            a2r * b1r - a2i * b1i + b2r, a2r * b1i + a2i * b1r + b2i)


def s5_scan(u, ar, ai, bbr, bbi, h0, reverse):
    xr = jnp.einsum('bngc,gpc->bngp', u, bbr)
    xi = jnp.einsum('bngc,gpc->bngp', u, bbi)
    if h0 is not None:
        h0r, h0i = h0
        pos = -1 if reverse else 0
        xr = xr.at[:, pos].add(ar * h0r - ai * h0i)
        xi = xi.at[:, pos].add(ar * h0i + ai * h0r)
    a_r = jnp.broadcast_to(ar, xr.shape)
    a_i = jnp.broadcast_to(ai, xr.shape)
    _, _, hr, hi = lax.associative_scan(_linear_recurrence_op, (a_r, a_i, xr, xi), axis=1, reverse=reverse)
    return hr, hi


def s5_readout(hr, hi, c_re, c_im):
    return jnp.einsum('bngp,gcp->bngc', hr, c_re) - jnp.einsum('bngp,gcp->bngc', hi, c_im)


def s5_glu(y, w_glu):
    y = jax.nn.gelu(y.reshape(y.shape[0], y.shape[1], S5_CH))
    return y * jax.nn.sigmoid(y @ w_glu.astype(F32))


def s5_mixer(u, uc, lam_re, lam_im, b_re, b_im, c_re, c_im, log_step, d_skip, w_glu, compute_ctx):
    def groups(t):
        return t.astype(F32).reshape(t.shape[0], t.shape[1], S5_GROUPS, S5_GROUP)

    ug, ucg = groups(u), groups(uc)
    d = d_skip.astype(F32).reshape(S5_GROUPS, S5_GROUP)
    y = ug * d
    yc = ucg * d if compute_ctx else None
    for direction, reverse in ((0, False), (1, True)):
        ar, ai, bbr, bbi = s5_discretize(lam_re[direction], lam_im[direction], b_re[direction],
                                         b_im[direction], log_step[direction])
        cr, ci = c_re[direction].astype(F32), c_im[direction].astype(F32)
        hcr, hci = s5_scan(ucg, ar, ai, bbr, bbi, None, reverse)
        end = 0 if reverse else -1
        hr, hi = s5_scan(ug, ar, ai, bbr, bbi, (hcr[:, end], hci[:, end]), reverse)
        y = y + s5_readout(hr, hi, cr, ci)
        if compute_ctx:
            yc = yc + s5_readout(hcr, hci, cr, ci)
    out = s5_glu(y, w_glu).astype(u.dtype)
    if not compute_ctx:
        return out, None
    return out, s5_glu(yc, w_glu).astype(uc.dtype)


def retention_chunkwise(q, k, v, log_g, s0):
    b, h, n, d = q.shape
    nc = n // RET_CHUNK
    idx = jnp.arange(RET_CHUNK, dtype=F32)
    diff = idx[:, None] - idx[None, :]
    intra = jnp.where(diff >= 0, jnp.exp(log_g[:, None, None] * jnp.maximum(diff, 0.0)), 0.0)
    q_dec = jnp.exp(log_g[:, None] * (idx + 1.0))[:, :, None]
    k_dec = jnp.exp(log_g[:, None] * (RET_CHUNK - 1.0 - idx))[:, :, None]
    c_dec = jnp.exp(log_g * RET_CHUNK)[:, None, None]

    def chunks(t):
        return jnp.moveaxis(t.reshape(b, h, nc, RET_CHUNK, t.shape[-1]), 2, 0)

    def step(s, inp):
        qb, kb, vb = inp
        att = jnp.einsum('bhid,bhjd->bhij', qb, kb) * intra
        o = jnp.einsum('bhij,bhjd->bhid', att, vb) + jnp.einsum('bhid,bhde->bhie', qb * q_dec, s)
        s = s * c_dec + jnp.einsum('bhjd,bhje->bhde', kb * k_dec, vb)
        return s, o

    s, o = lax.scan(step, s0, (chunks(q), chunks(k), chunks(v)))
    return jnp.moveaxis(o, 0, 2).reshape(b, h, n, v.shape[-1]), s


def retention_final_state(k, v, log_g):
    n = k.shape[2]
    w = jnp.exp(log_g[:, None] * (n - 1.0 - jnp.arange(n, dtype=F32)))
    return jnp.einsum('bhnd,bhne->bhde', k * w[..., None], v)


def retention_mixer(q, k, v, g, qc, kc, vc, gc, decay_logit, compute_ctx):
    def heads(t):
        return t.astype(F32).reshape(t.shape[0], t.shape[1], RET_HEADS, RET_HEAD_DIM).transpose(0, 2, 1, 3)

    def gated(o, gate):
        bb, nh, n, d = o.shape
        o = rms_norm(o).transpose(0, 2, 1, 3).reshape(bb, n, nh * d)
        return (o * jax.nn.silu(gate.astype(F32))).astype(gate.dtype)

    scale = RET_HEAD_DIM ** -0.5
    log_g = jax.nn.log_sigmoid(decay_logit.astype(F32))
    q_, k_, v_ = heads(q), heads(k) * scale, heads(v)
    kc_, vc_ = heads(kc) * scale, heads(vc)
    qc_ = heads(qc) if compute_ctx else None
    s_zero = jnp.zeros((q.shape[0], RET_HEADS, RET_HEAD_DIM, RET_HEAD_DIM), F32)
    o = None
    oc = None
    for direction, rev in ((0, False), (1, True)):
        lg = log_g[direction]
        fl = (lambda t: jnp.flip(t, axis=2)) if rev else (lambda t: t)
        if compute_ctx:
            oc_dir, s_ctx = retention_chunkwise(fl(qc_), fl(kc_), fl(vc_), lg, s_zero)
            oc = fl(oc_dir) if oc is None else oc + fl(oc_dir)
        else:
            s_ctx = retention_final_state(fl(kc_), fl(vc_), lg)
        o_dir, _ = retention_chunkwise(fl(q_), fl(k_), fl(v_), lg, s_ctx)
        o = fl(o_dir) if o is None else o + fl(o_dir)
    y = gated(o, g)
    if not compute_ctx:
        return y, None
    return y, gated(oc, gc)


def odd_mixer(h, hc, w_in, w_out, lam_re, lam_im, b_re, b_im, c_re, c_im, log_step, d_skip, w_glu,
              decay_logit, compute_ctx):
    sizes = [S5_CH] + [RET_WIDTH] * 4
    u, q, k, v, g = split_cols(h @ w_in, sizes)
    uc, qc, kc, vc, gc = split_cols(hc @ w_in, sizes)
    y_c, yc_c = s5_mixer(u, uc, lam_re, lam_im, b_re, b_im, c_re, c_im, log_step, d_skip, w_glu, compute_ctx)
    y_d, yc_d = retention_mixer(q, k, v, g, qc, kc, vc, gc, decay_logit, compute_ctx)
    y = jnp.concatenate([y_c, y_d], axis=-1) @ w_out
    if not compute_ctx:
        return y, None
    return y, jnp.concatenate([yc_c, yc_d], axis=-1) @ w_out


def setup_inputs(seed: int = 0) -> dict:
    key = jax.random.key(seed)
    ks = iter(jax.random.split(key, 40))
    D = D_MODEL

    def nrm(shape, scale):
        return jax.random.normal(next(ks), shape, F32) * scale

    x = nrm((BATCH, SEQ, D), 1.0)
    c = nrm((BATCH, D), 1.0)
    ctx = nrm((BATCH, CTX_LEN, D), 1.0)
    c_ctx = nrm((D,), 1.0)
    ada_w = nrm((DEPTH, D, 6 * D), 0.5 * D ** -0.5)
    ada_b = nrm((DEPTH, 6 * D), 0.02)
    norm1_w = 1.0 + nrm((DEPTH, D), 0.02)
    norm2_w = 1.0 + nrm((DEPTH, D), 0.02)
    ffn_w13 = nrm((DEPTH, D, 2 * D_FF), D ** -0.5)
    ffn_w2 = nrm((DEPTH, D_FF, D), D_FF ** -0.5)
    e_w_in = nrm((N_EVEN, D, EVEN_IN), D ** -0.5)
    e_w_out = nrm((N_EVEN, EVEN_OUT, D), EVEN_OUT ** -0.5)
    diff_lq1 = nrm((N_EVEN, A_QK_DIM), 0.1)
    diff_lk1 = nrm((N_EVEN, A_QK_DIM), 0.1)
    diff_lq2 = nrm((N_EVEN, A_QK_DIM), 0.1)
    diff_lk2 = nrm((N_EVEN, A_QK_DIM), 0.1)
    diff_subln_w = 1.0 + nrm((N_EVEN, A_V_DIM), 0.02)
    na_rpb = nrm((N_EVEN, B_HEADS, 2 * WIN_R - 1, 2 * WIN_C - 1), 0.1)
    o_w_in = nrm((N_ODD, D, ODD_IN), D ** -0.5)
    o_w_out = nrm((N_ODD, ODD_OUT, D), ODD_OUT ** -0.5)
    ssm_shape = (N_ODD, 2, S5_GROUPS, S5_STATE)
    s5_lam_re = -0.5 + nrm(ssm_shape, 0.01)
    s5_lam_im = math.pi * jnp.arange(S5_STATE, dtype=F32) + nrm(ssm_shape, 0.01)
    s5_b_re = nrm(ssm_shape + (S5_GROUP,), (2.0 * S5_GROUP) ** -0.5)
    s5_b_im = nrm(ssm_shape + (S5_GROUP,), (2.0 * S5_GROUP) ** -0.5)
    s5_c_re = nrm((N_ODD, 2, S5_GROUPS, S5_GROUP, S5_STATE), (2.0 * S5_STATE) ** -0.5)
    s5_c_im = nrm((N_ODD, 2, S5_GROUPS, S5_GROUP, S5_STATE), (2.0 * S5_STATE) ** -0.5)
    s5_log_step = jax.random.uniform(next(ks), (N_ODD, 2, S5_GROUPS), F32,
                                     minval=math.log(1e-3), maxval=math.log(1e-1))
    s5_d = nrm((N_ODD, S5_CH), 1.0)
    s5_w_glu = nrm((N_ODD, S5_CH, S5_CH), S5_CH ** -0.5)
    h_idx = jnp.arange(RET_HEADS, dtype=F32)
    gamma = 1.0 - 2.0 ** (-5.0 - h_idx)
    gamma_logit = jnp.log(gamma) + (5.0 + h_idx) * math.log(2.0)
    ret_decay_logit = gamma_logit + nrm((N_ODD, 2, RET_HEADS), 0.05)
    final_norm_w = 1.0 + nrm((D,), 0.02)
    return {"x": x, "c": c, "ctx": ctx, "c_ctx": c_ctx, "ada_w": ada_w, "ada_b": ada_b,
            "norm1_w": norm1_w, "norm2_w": norm2_w, "ffn_w13": ffn_w13, "ffn_w2": ffn_w2,
            "e_w_in": e_w_in, "e_w_out": e_w_out, "diff_lq1": diff_lq1, "diff_lk1": diff_lk1,
            "diff_lq2": diff_lq2, "diff_lk2": diff_lk2, "diff_subln_w": diff_subln_w, "na_rpb": na_rpb,
            "o_w_in": o_w_in, "o_w_out": o_w_out, "s5_lam_re": s5_lam_re, "s5_lam_im": s5_lam_im,
            "s5_b_re": s5_b_re, "s5_b_im": s5_b_im, "s5_c_re": s5_c_re, "s5_c_im": s5_c_im,
            "s5_log_step": s5_log_step, "s5_d": s5_d, "s5_w_glu": s5_w_glu,
            "ret_decay_logit": ret_decay_logit, "final_norm_w": final_norm_w}


def reference(x, c, ctx, c_ctx, ada_w, ada_b, norm1_w, norm2_w, ffn_w13, ffn_w2,
              e_w_in, e_w_out, diff_lq1, diff_lk1, diff_lq2, diff_lk2, diff_subln_w, na_rpb,
              o_w_in, o_w_out, s5_lam_re, s5_lam_im, s5_b_re, s5_b_im, s5_c_re, s5_c_im,
              s5_log_step, s5_d, s5_w_glu, ret_decay_logit, final_norm_w):
    n_lat = x.shape[1]
    rope_cos, rope_sin = axial_rope_tables(n_lat, A_QK_DIM)
    sc = jax.nn.silu(c)
    scc = jax.nn.silu(c_ctx)
    xc = ctx
    for i in range(DEPTH):
        last = i == DEPTH - 1
        compute_ctx = not last
        mod = jnp.split(sc @ ada_w[i] + ada_b[i], 6, axis=-1)
        n_mc = 6 if compute_ctx else 2
        modc = jnp.split(scc @ ada_w[i][:, :n_mc * D_MODEL] + ada_b[i][:n_mc * D_MODEL], n_mc, axis=-1)
        h = modulate(rms_norm(x, norm1_w[i]), mod[0][:, None], mod[1][:, None])
        hc = modulate(rms_norm(xc, norm1_w[i]), modc[0], modc[1])
        if i % 2 == 0:
            j = i // 2
            lambda_init = 0.8 - 0.6 * math.exp(-0.3 * i)
            y, yc = even_mixer(h, hc, e_w_in[j], e_w_out[j], diff_lq1[j], diff_lk1[j], diff_lq2[j], diff_lk2[j],
                               diff_subln_w[j], na_rpb[j], lambda_init, rope_cos, rope_sin, compute_ctx)
        else:
            j = i // 2
            y, yc = odd_mixer(h, hc, o_w_in[j], o_w_out[j], s5_lam_re[j], s5_lam_im[j], s5_b_re[j], s5_b_im[j],
                              s5_c_re[j], s5_c_im[j], s5_log_step[j], s5_d[j], s5_w_glu[j],
                              ret_decay_logit[j], compute_ctx)
        x = x + mod[2][:, None] * y
        h = modulate(rms_norm(x, norm2_w[i]), mod[3][:, None], mod[4][:, None])
        x = x + mod[5][:, None] * swiglu(h, ffn_w13[i], ffn_w2[i])
        if compute_ctx:
            xc = xc + modc[2] * yc
            hc = modulate(rms_norm(xc, norm2_w[i]), modc[3], modc[4])
            xc = xc + modc[5] * swiglu(hc, ffn_w13[i], ffn_w2[i])
    return rms_norm(x, final_norm_w)
```

```cpp
#include <hip/hip_runtime.h>
#include <cstdio>
#include <cstdint>

#define LAS __attribute__((address_space(3)))
#define GAS __attribute__((address_space(1)))
typedef unsigned short bf16_t;
typedef short bf16x8 __attribute__((ext_vector_type(8)));
typedef short s16x4 __attribute__((ext_vector_type(4)));
typedef float f32x2 __attribute__((ext_vector_type(2)));
typedef float f32x4 __attribute__((ext_vector_type(4)));
typedef float f32x16 __attribute__((ext_vector_type(16)));
typedef unsigned u32x2 __attribute__((ext_vector_type(2)));
typedef unsigned u32x4 __attribute__((ext_vector_type(4)));

typedef _Float16 h16;
typedef _Float16 h16x8 __attribute__((ext_vector_type(8)));
typedef _Float16 h16x4 __attribute__((ext_vector_type(4)));
typedef float f32x8 __attribute__((ext_vector_type(8)));
__device__ __forceinline__ void ld8h(const h16* p, f32x4& a, f32x4& b) { const h16x8 h = *(const h16x8*)p; const f32x8 f = __builtin_convertvector(h, f32x8); a = (f32x4){f[0], f[1], f[2], f[3]}; b = (f32x4){f[4], f[5], f[6], f[7]}; }
__device__ __forceinline__ void st8h(h16* p, const f32x4 a, const f32x4 b) { const f32x8 f = {a.x, a.y, a.z, a.w, b.x, b.y, b.z, b.w}; *(h16x8*)p = __builtin_convertvector(f, h16x8); }
constexpr int DM = 2048, SEQ = 16384, NCTX = 256, NT = SEQ + NCTX;
constexpr int DFF = 5632, LDP = 6144;
constexpr int NIN_E = 6144, NIN_O = 6656;
constexpr float LOG2E = 1.4426950408889634f;
constexpr float EPS = 1e-6f;

constexpr size_t MiB = 1u << 20;
constexpr size_t WS_CTL = 0, CTL_ZERO_BYTES = 1 * MiB;
constexpr size_t WS_MOD = 1 * MiB;
constexpr size_t WS_ROPE = WS_MOD + 512 * 1024;
constexpr size_t WS_LAM = WS_ROPE + 64 * 1024;
constexpr size_t WS_WIN = 2 * MiB;
constexpr size_t WS_WOUT = WS_WIN + 4 * 26 * MiB;
constexpr size_t WS_W13 = WS_WOUT + 4 * 8 * MiB;
constexpr size_t WS_W2 = WS_W13 + 4 * 44 * MiB;
constexpr size_t WS_XW = WS_W2 + 4 * 22 * MiB;
constexpr size_t WS_H = WS_XW + 130 * MiB;
constexpr size_t WS_PROJ = WS_H + 65 * MiB;
constexpr size_t WS_MIX = WS_PROJ + 195 * MiB;
constexpr size_t WS_U = WS_MIX + 65 * MiB;
constexpr size_t WS_Y2 = WS_U + 33 * MiB;
constexpr size_t WS_OR = WS_Y2 + 65 * MiB;
constexpr size_t WS_O1 = WS_OR + 195 * MiB;
constexpr size_t WS_UC = WS_O1 + 65 * MiB;
constexpr size_t WS_A2 = WS_UC + 20 * MiB;
constexpr size_t WS_E = WS_A2 + 40 * MiB;
constexpr size_t WS_YG = WS_E + 40 * MiB;
constexpr size_t WS_W1T = WS_YG + 17 * MiB;
constexpr size_t WS_W2T = WS_W1T + 8 * MiB;
constexpr size_t WS_WGT = WS_W2T + 16 * MiB;
constexpr size_t WS_END = WS_WGT + 1 * MiB;
static_assert((size_t)NT * DM * 4 <= 130 * MiB && (size_t)NT * LDP * 2 <= 195 * MiB && (size_t)NT * 1536 * 4 * 2 <= 195 * MiB, "ws map");

constexpr int CW_BAR = 4096, BAR_STRIDE = 4096, CW_KM = 131072;

constexpr int RING_BYTES = 131072;
constexpr int LDSCTL_OFF = RING_BYTES, MISC_OFF = LDSCTL_OFF + 320;
constexpr int LDS_BYTES = 147456;

__device__ __forceinline__ float bf2f(unsigned short b) { return __uint_as_float((unsigned)b << 16); }
__device__ __forceinline__ unsigned cvt_pk_bf16(float lo, float hi) { unsigned r; asm volatile("v_cvt_pk_bf16_f32 %0, %1, %2" : "=v"(r) : "v"(lo), "v"(hi)); return r; }
template <int M> __device__ __forceinline__ float swz_xor(float v) { return __int_as_float(__builtin_amdgcn_ds_swizzle(__float_as_int(v), (M << 10) | 0x1f)); }
__device__ __forceinline__ float half_sum32(float v) { v += swz_xor<1>(v); v += swz_xor<2>(v); v += swz_xor<4>(v); v += swz_xor<8>(v); v += swz_xor<16>(v); return v; }
__device__ __forceinline__ float wave_sum(float v) {
    v = half_sum32(v);
    auto rr = __builtin_amdgcn_permlane32_swap(__float_as_uint(v), __float_as_uint(v), false, false);
    return __uint_as_float(rr[0]) + __uint_as_float(rr[1]);
}
__device__ __forceinline__ float wave_max(float v) {
    v = fmaxf(v, swz_xor<1>(v)); v = fmaxf(v, swz_xor<2>(v)); v = fmaxf(v, swz_xor<4>(v)); v = fmaxf(v, swz_xor<8>(v)); v = fmaxf(v, swz_xor<16>(v));
    auto rr = __builtin_amdgcn_permlane32_swap(__float_as_uint(v), __float_as_uint(v), false, false);
    return fmaxf(__uint_as_float(rr[0]), __uint_as_float(rr[1]));
}
__device__ __forceinline__ float xor32(float v, int hi) { auto rr = __builtin_amdgcn_permlane32_swap(__float_as_uint(v), __float_as_uint(v), false, false); return __uint_as_float(hi ? rr[0] : rr[1]); }
__device__ __forceinline__ float silu_f(float x) { return x / (1.f + __expf(-x)); }
__device__ __forceinline__ int lane_now() { int l; asm volatile("v_mbcnt_lo_u32_b32 %0, -1, 0\n\tv_mbcnt_hi_u32_b32 %0, -1, %0" : "=v"(l)); return l; }
#define LDS_WAIT() asm volatile("s_waitcnt lgkmcnt(0)" ::: "memory")
#define VM_WAIT() asm volatile("s_waitcnt vmcnt(0)" ::: "memory")

namespace pg8 {
constexpr int BM = 256, BK = 64, HALF = 128, HTB = HALF * BK * 2, STAGE_BYTES = 8 * HTB, NXCD = 8, WGM = 8;
__host__ __device__ __forceinline__ int lds_byte(int r, int c) { const int st = (r >> 4) * 2 + (c >> 5), rr = r & 15, cc = c & 31, ob = rr * 64 + cc * 2; return st * 1024 + (ob ^ (((ob >> 9) & 1) << 5)); }
__host__ __device__ __forceinline__ void stage_rc(int b, int& R, int& C) { const int st = b / 1024, sb = b % 1024, swz = sb ^ (((sb >> 9) & 1) << 5); R = (st >> 1) * 16 + swz / 64; C = (st & 1) * 32 + (swz % 64) / 2; }
__host__ __device__ __forceinline__ int perm32(int rho) { const int n = rho >> 4, i = rho & 15; return 8 * (i >> 2) + 4 * n + (i & 3); }

struct Unit { int pm, pn, kt0, ntu; };
struct Gemm { const bf16_t* A; const bf16_t* Bt; int M, N, K, lda, ldb; };

struct StaticOrder {
    int nM, nN, nwg, G, c, pm0;
    __host__ __device__ void init(int nM_, int nN_, int G_, int c_, int pm0_) { nM = nM_; nN = nN_; nwg = nM * nN; G = G_; c = c_; pm0 = pm0_; }
    __host__ __device__ bool next(int i, Unit& u) const {
        const long L = (long)i * G + c; if (L >= nwg) return false;
        int wgid = (int)L; { const int q = nwg / NXCD, r = nwg % NXCD, xcd = wgid % NXCD, off = wgid / NXCD; wgid = (xcd < r ? xcd * (q + 1) : r * (q + 1) + (xcd - r) * q) + off; }
        const int nig = WGM * nN, gid = wgid / nig, fm = gid * WGM, gsz = (nM - fm) < WGM ? (nM - fm) : WGM;
        u.pm = pm0 + fm + ((wgid % nig) % gsz); u.pn = (wgid % nig) / gsz; u.kt0 = 0; u.ntu = 0; return true;
    }
    __device__ __forceinline__ void a_ready(const Unit&) const {}
    __device__ __forceinline__ void done(const Unit&) const {}
};

struct SplitOrder {
    StaticOrder so; int nmini, ntp;
    __host__ __device__ bool next(int i, Unit& u) const {
        if (so.next(i, u)) return true;
        const long L = (long)i * so.G + so.c - (long)(((so.nwg + so.G - 1) / so.G) * so.G);
        if (L < 0 || L >= nmini) return false;
        u.pm = 0; u.pn = (int)L & 7; u.kt0 = ((int)L >> 3) * ntp; u.ntu = ntp; return true;
    }
    __device__ __forceinline__ void a_ready(const Unit&) const {}
    __device__ __forceinline__ void done(const Unit&) const {}
};
template <class Epi, class Sched, bool ALIGN_EPI = false, bool SP2 = false>
__device__ __forceinline__ void gemm_phase(LAS unsigned char* lds, const Gemm g, const Sched& S, const Epi& E, const int wv) {
    const int wid = wv, lane = lane_now(), tid = wid * 64 + lane;
    const int wr = wid >> 2, wc = wid & 3, fr = lane & 15, fq = lane >> 4;
    const int K = g.K, nt = K / BK;
    unsigned voffA[2], voffB[2];
#pragma unroll
    for (int i = 0; i < 2; ++i) { int R, C; stage_rc(tid * 16 + i * 8192, R, C); const int Rb = Epi::PERM ? ((R & ~31) + perm32(R & 31)) : R;
        voffA[i] = (unsigned)(R * K + C) * 2u; voffB[i] = (unsigned)(Rb * K + C) * 2u; }
    const size_t kstep = (size_t)(BK * 2);
    const size_t hA = (size_t)HALF * K * 2;
#define hB hA
#define tA (2 * hA)
#define tB (2 * hA)
    const unsigned ldsw = (unsigned)wid * 1024u;
    const int aoff = lds_byte(wr * 64 + fr, fq * 8), boff = lds_byte(wc * 32 + fr, fq * 8);
#define PG8_SA(b, h) (((b) * 2 + (h)) * HTB)
#define PG8_SB(b, h) ((4 + (b) * 2 + (h)) * HTB)
#define PG8_STAGE(bufoff, gbase, voff) do { _Pragma("unroll") for (int _i = 0; _i < 2; ++_i) \
        __builtin_amdgcn_global_load_lds((const unsigned*)((const char*)(gbase) + (voff)[_i]), (LAS unsigned*)(lds + (bufoff) + ldsw + _i * 8192), 16, 0, 0); } while (0)
#define PG8_LDA(dst, b, h) do { _Pragma("unroll") for (int m = 0; m < 4; ++m) _Pragma("unroll") for (int k = 0; k < 2; ++k) dst[m][k] = *(const LAS bf16x8*)(lds + PG8_SA(b, h) + aoff + m * 2048 + k * 1024); } while (0)
#define PG8_LDB(dst, b, h) do { _Pragma("unroll") for (int n = 0; n < 2; ++n) _Pragma("unroll") for (int k = 0; k < 2; ++k) dst[n][k] = *(const LAS bf16x8*)(lds + PG8_SB(b, h) + boff + n * 2048 + k * 1024); } while (0)
#define PG8_MMA(ai, bj, At, Bt) do { __builtin_amdgcn_s_setprio(1); _Pragma("unroll") for (int m = 0; m < 4; ++m) _Pragma("unroll") for (int n = 0; n < 2; ++n) _Pragma("unroll") for (int k = 0; k < 2; ++k) \
        acc[ai][bj][m][n] = __builtin_amdgcn_mfma_f32_16x16x32_bf16(Bt[n][k], At[m][k], acc[ai][bj][m][n], 0, 0, 0); __builtin_amdgcn_s_setprio(0); } while (0)
#define PG8_WAIT_V(n) asm volatile("s_waitcnt vmcnt(" #n ")" ::: "memory")
#define PG8_WAIT_L(n) asm volatile("s_waitcnt lgkmcnt(" #n ")" ::: "memory")
#define PG8_BAR __builtin_amdgcn_s_barrier()
#define PG8_SCHED __builtin_amdgcn_sched_barrier(0)
    Unit cur, nxt; int ui = 0;
    if (!S.next(0, cur)) return;
    f32x4 acc[2][2][4][2];
#pragma unroll
    for (int a = 0; a < 2; ++a)
#pragma unroll
        for (int b = 0; b < 2; ++b)
#pragma unroll
            for (int m = 0; m < 4; ++m)
#pragma unroll
                for (int n = 0; n < 2; ++n) acc[a][b][m][n] = (f32x4){0.f, 0.f, 0.f, 0.f};
    bf16x8 At[4][2], B0[2][2], B1[2][2];
    const char* cA = (const char*)g.A + (size_t)cur.pm * tA + (size_t)cur.kt0 * kstep; const char* cB = (const char*)g.Bt + (size_t)cur.pn * tB + (size_t)cur.kt0 * kstep;
    S.a_ready(cur);
    if constexpr (SP2) {
        PG8_STAGE(PG8_SB(0, 0), cB, voffB); PG8_STAGE(PG8_SB(0, 1), cB + hB, voffB); PG8_STAGE(PG8_SA(0, 0), cA, voffA); PG8_STAGE(PG8_SA(0, 1), cA + hA, voffA);
        if (wr == 1) PG8_BAR;
        PG8_WAIT_V(2); PG8_BAR;
        PG8_STAGE(PG8_SB(1, 0), cB + kstep, voffB); PG8_STAGE(PG8_SA(1, 0), cA + kstep, voffA); PG8_STAGE(PG8_SB(1, 1), cB + hB + kstep, voffB);
        PG8_WAIT_V(6); PG8_BAR;
    } else {
        PG8_STAGE(PG8_SB(0, 0), cB, voffB); PG8_STAGE(PG8_SA(0, 0), cA, voffA); PG8_STAGE(PG8_SB(0, 1), cB + hB, voffB); PG8_STAGE(PG8_SA(0, 1), cA + hA, voffA);
        if (wr == 1) PG8_BAR;
        PG8_WAIT_V(4); PG8_BAR;
        PG8_STAGE(PG8_SB(1, 0), cB + kstep, voffB); PG8_STAGE(PG8_SA(1, 0), cA + kstep, voffA); PG8_STAGE(PG8_SB(1, 1), cB + hB + kstep, voffB);
        PG8_WAIT_V(6); PG8_BAR;
    }
    for (;;) {
        const bool has_next = S.next(ui + 1, nxt);
        const char* nA = has_next ? (const char*)g.A + (size_t)nxt.pm * tA + (size_t)nxt.kt0 * kstep : cA; const char* nB = has_next ? (const char*)g.Bt + (size_t)nxt.pn * tB + (size_t)nxt.kt0 * kstep : cB;
        const int ntc = cur.ntu > 0 ? cur.ntu : nt;
        for (int t = 0; t < ntc; t += 2) {
            const bool last = (t == ntc - 2);
            const char* a1 = cA + (size_t)(t + 1) * kstep;
            const char* a2 = last ? nA : cA + (size_t)(t + 2) * kstep; const char* b2 = last ? nB : cB + (size_t)(t + 2) * kstep;
            const char* a3 = a2 + kstep; const char* b3 = b2 + kstep;
            if (last && has_next) S.a_ready(nxt);
            if constexpr (SP2) {
            PG8_LDB(B0, 0, 0); PG8_LDB(B1, 0, 1); PG8_SCHED; PG8_LDA(At, 0, 0); PG8_STAGE(PG8_SA(1, 1), a1 + hA, voffA);
            PG8_WAIT_V(8); PG8_WAIT_L(0); PG8_BAR; PG8_MMA(0, 0, At, B0); PG8_MMA(0, 1, At, B1); PG8_BAR; PG8_SCHED;
            PG8_LDA(At, 0, 1); PG8_STAGE(PG8_SB(0, 0), b2, voffB); PG8_STAGE(PG8_SB(0, 1), b2 + hB, voffB); PG8_STAGE(PG8_SA(0, 0), a2, voffA);
            PG8_WAIT_V(8); PG8_WAIT_L(0); PG8_BAR; PG8_MMA(1, 0, At, B0); PG8_MMA(1, 1, At, B1); PG8_BAR; PG8_SCHED;
            PG8_LDB(B0, 1, 0); PG8_LDB(B1, 1, 1); PG8_SCHED; PG8_LDA(At, 1, 0); PG8_STAGE(PG8_SA(0, 1), a2 + hA, voffA);
            PG8_WAIT_V(8); PG8_WAIT_L(0); PG8_BAR; PG8_MMA(0, 0, At, B0); PG8_MMA(0, 1, At, B1); PG8_BAR; PG8_SCHED;
            PG8_LDA(At, 1, 1); PG8_STAGE(PG8_SB(1, 0), b3, voffB); PG8_STAGE(PG8_SB(1, 1), b3 + hB, voffB); PG8_STAGE(PG8_SA(1, 0), a3, voffA);
            PG8_WAIT_V(8); PG8_WAIT_L(0); PG8_BAR; PG8_MMA(1, 0, At, B0); PG8_MMA(1, 1, At, B1); PG8_BAR; PG8_SCHED;
            } else {
            PG8_LDB(B0, 0, 0); PG8_SCHED; PG8_LDA(At, 0, 0); PG8_STAGE(PG8_SA(1, 1), a1 + hA, voffA);
            PG8_WAIT_L(8); PG8_BAR; PG8_WAIT_L(0); PG8_MMA(0, 0, At, B0); PG8_BAR; PG8_SCHED;
            PG8_LDB(B1, 0, 1); PG8_STAGE(PG8_SB(0, 0), b2, voffB);
            PG8_BAR; PG8_WAIT_L(0); PG8_MMA(0, 1, At, B1); PG8_BAR;
            PG8_LDA(At, 0, 1); PG8_STAGE(PG8_SA(0, 0), a2, voffA);
            PG8_BAR; PG8_WAIT_L(0); PG8_MMA(1, 0, At, B0); PG8_BAR; PG8_SCHED;
            PG8_STAGE(PG8_SB(0, 1), b2 + hB, voffB);
            PG8_WAIT_V(6); PG8_BAR; PG8_MMA(1, 1, At, B1); PG8_BAR;
            PG8_LDB(B0, 1, 0); PG8_SCHED; PG8_LDA(At, 1, 0); PG8_STAGE(PG8_SA(0, 1), a2 + hA, voffA);
            PG8_WAIT_L(8); PG8_BAR; PG8_WAIT_L(0); PG8_MMA(0, 0, At, B0); PG8_BAR; PG8_SCHED;
            PG8_LDB(B1, 1, 1); PG8_STAGE(PG8_SB(1, 0), b3, voffB);
            PG8_BAR; PG8_WAIT_L(0); PG8_MMA(0, 1, At, B1); PG8_BAR;
            PG8_LDA(At, 1, 1); PG8_STAGE(PG8_SA(1, 0), a3, voffA);
            PG8_BAR; PG8_WAIT_L(0); PG8_MMA(1, 0, At, B0); PG8_BAR; PG8_SCHED;
            PG8_STAGE(PG8_SB(1, 1), b3 + hB, voffB);
            PG8_WAIT_V(6); PG8_BAR; PG8_MMA(1, 1, At, B1); PG8_BAR;
            }
        }
        if constexpr (ALIGN_EPI) { if (wr == 0) PG8_BAR; }
        { const int t2 = lane_now(); E(acc, cur, wr, wc, t2 & 15, t2 >> 4); } S.done(cur);
        if (!has_next) break;
#pragma unroll
        for (int a = 0; a < 2; ++a)
#pragma unroll
            for (int b = 0; b < 2; ++b)
#pragma unroll
                for (int m = 0; m < 4; ++m)
#pragma unroll
                    for (int n = 0; n < 2; ++n) acc[a][b][m][n] = (f32x4){0.f, 0.f, 0.f, 0.f};
        cur = nxt; cA = nA; cB = nB; ++ui;
        if constexpr (ALIGN_EPI) { if (wr == 1) PG8_BAR; }
    }
    PG8_WAIT_V(0);
    if constexpr (!ALIGN_EPI) { if (wr == 0) PG8_BAR; }
    PG8_BAR;
#undef hB
#undef tA
#undef tB
#undef PG8_SA
#undef PG8_SB
#undef PG8_STAGE
#undef PG8_LDA
#undef PG8_LDB
#undef PG8_MMA
#undef PG8_WAIT_V
#undef PG8_WAIT_L
#undef PG8_BAR
#undef PG8_SCHED
}

struct EpiEvenIn {
    static constexpr bool PERM = true;
    bf16_t* P; const float* rope; unsigned* km;
    __device__ __forceinline__ void operator()(const f32x4 (&acc)[2][2][4][2], const Unit& u, int wr, int wc, int fr, int fq) const {
        const int region = u.pn >> 2;
        float kmax2[2] = {0.f, 0.f};
        const bool dorope = (region <= 1) && (u.pm != 0);
        const float sc = region == 0 ? 0.125f * LOG2E : (region == 3 ? 0.08838834764831845f * LOG2E : 1.f);
        const int colbase = u.pn * BM + wc * 32 + 8 * fq;
        const float sgn = (fq & 2) ? 1.f : -1.f;
#pragma unroll
        for (int ai = 0; ai < 2; ++ai)
#pragma unroll
            for (int m = 0; m < 4; ++m) {
                const int row = u.pm * BM + ai * HALF + wr * 64 + m * 16 + fr;
                f32x4 cs[4];
                if (dorope) { const int t = row - NCTX; const int pos = (wc & 1) ? (t & 63) : (t >> 6);
                    const f32x4* tb = (const f32x4*)(rope + (pos * 16 + 8 * (fq & 1)) * 2);
#pragma unroll
                    for (int q = 0; q < 4; ++q) cs[q] = tb[q]; }
#pragma unroll
                for (int bj = 0; bj < 2; ++bj) {
                    f32x4 v0 = acc[ai][bj][m][0], v1 = acc[ai][bj][m][1];
                    if (dorope) {
                        f32x4 p0, p1;
#pragma unroll
                        for (int e = 0; e < 4; ++e) { p0[e] = xor32(v0[e], fq >> 1); p1[e] = xor32(v1[e], fq >> 1); }
                        v0[0] = v0[0] * cs[0][0] + sgn * p0[0] * cs[0][1]; v0[1] = v0[1] * cs[0][2] + sgn * p0[1] * cs[0][3];
                        v0[2] = v0[2] * cs[1][0] + sgn * p0[2] * cs[1][1]; v0[3] = v0[3] * cs[1][2] + sgn * p0[3] * cs[1][3];
                        v1[0] = v1[0] * cs[2][0] + sgn * p1[0] * cs[2][1]; v1[1] = v1[1] * cs[2][2] + sgn * p1[1] * cs[2][3];
                        v1[2] = v1[2] * cs[3][0] + sgn * p1[2] * cs[3][1]; v1[3] = v1[3] * cs[3][2] + sgn * p1[3] * cs[3][3];
                    }
                    v0 = v0 * sc; v1 = v1 * sc;
                    if (region == 1) { float ss = (v0[0] * v0[0] + v0[1] * v0[1]) + (v0[2] * v0[2] + v0[3] * v0[3]) + (v1[0] * v1[0] + v1[1] * v1[1]) + (v1[2] * v1[2] + v1[3] * v1[3]);
                        ss += swz_xor<16>(ss); ss += xor32(ss, fq >> 1); kmax2[bj] = fmaxf(kmax2[bj], ss); }
                    u32x4 w; w.x = cvt_pk_bf16(v0[0], v0[1]); w.y = cvt_pk_bf16(v0[2], v0[3]); w.z = cvt_pk_bf16(v1[0], v1[1]); w.w = cvt_pk_bf16(v1[2], v1[3]);
                    *(u32x4*)(P + (size_t)row * LDP + colbase + bj * HALF) = w;
                }
            }
        if (region == 1) {
#pragma unroll
            for (int bj = 0; bj < 2; ++bj) { const float mx = wave_max(kmax2[bj]);
                if ((fr | fq) == 0) __hip_atomic_fetch_max(km + ((2 * (u.pn - 4) + bj) * 2 + (wc >> 1)) * 2 + (wc & 1), __float_as_uint(mx), __ATOMIC_RELAXED, __HIP_MEMORY_SCOPE_AGENT); }
        }
    }
};
struct EpiResid {
    static constexpr bool PERM = true;
    h16* X; const float* Xin; const float* gate_lat; const float* gate_ctx; float* slab;
    __device__ __forceinline__ void operator()(const f32x4 (&acc)[2][2][4][2], const Unit& u, int wr, int wc, int fr, int fq) const {
        const int colbase = u.pn * BM + wc * 32 + 8 * fq;
        const float* gp = (u.pm == 0 ? gate_ctx : gate_lat) + colbase;
        f32x4 g[2][2];
#pragma unroll
        for (int bj = 0; bj < 2; ++bj) { g[bj][0] = *(const f32x4*)(gp + bj * HALF); g[bj][1] = *(const f32x4*)(gp + bj * HALF + 4); }
        if (u.ntu > 0) {
#pragma unroll
            for (int ai = 0; ai < 2; ++ai)
#pragma unroll
                for (int m = 0; m < 4; ++m) { const int row = ai * HALF + wr * 64 + m * 16 + fr;
#pragma unroll
                    for (int bj = 0; bj < 2; ++bj) { float* sp = slab + ((size_t)(u.kt0 / u.ntu) * NCTX + row) * DM + colbase + bj * HALF;
                        *(f32x4*)sp = g[bj][0] * acc[ai][bj][m][0]; *(f32x4*)(sp + 4) = g[bj][1] * acc[ai][bj][m][1]; } }
            return;
        }
#pragma unroll
        for (int ai = 0; ai < 2; ++ai) {
            f32x4 xv[4][2][2];
#pragma unroll
            for (int m = 0; m < 4; ++m) { const size_t row = (size_t)(u.pm * BM + ai * HALF + wr * 64 + m * 16 + fr);
#pragma unroll
                for (int bj = 0; bj < 2; ++bj) {
                    if (Xin != nullptr) { const float* xp = Xin + (row - NCTX) * DM + colbase + bj * HALF; xv[m][bj][0] = *(const f32x4*)xp; xv[m][bj][1] = *(const f32x4*)(xp + 4); }
                    else ld8h(X + row * DM + colbase + bj * HALF, xv[m][bj][0], xv[m][bj][1]); } }
            asm volatile("" ::: "memory");
#pragma unroll
            for (int m = 0; m < 4; ++m) { h16* xp = X + (size_t)(u.pm * BM + ai * HALF + wr * 64 + m * 16 + fr) * DM + colbase;
#pragma unroll
                for (int bj = 0; bj < 2; ++bj) st8h(xp + bj * HALF, xv[m][bj][0] + g[bj][0] * acc[ai][bj][m][0], xv[m][bj][1] + g[bj][1] * acc[ai][bj][m][1]); }
        }
    }
};
struct EpiSwiglu {
    static constexpr bool PERM = true;
    bf16_t* ACT;
    __device__ __forceinline__ void operator()(const f32x4 (&acc)[2][2][4][2], const Unit& u, int wr, int wc, int fr, int fq) const {
        const int colbase = u.pn * HALF + wc * 32 + 8 * fq;
#pragma unroll
        for (int ai = 0; ai < 2; ++ai)
#pragma unroll
            for (int m = 0; m < 4; ++m) {
                const int row = u.pm * BM + ai * HALF + wr * 64 + m * 16 + fr;
                float r[8];
#pragma unroll
                for (int n = 0; n < 2; ++n)
#pragma unroll
                    for (int e = 0; e < 4; ++e) { const float a = acc[ai][0][m][n][e], b = acc[ai][1][m][n][e]; r[n * 4 + e] = a * __builtin_amdgcn_rcpf(1.f + __expf(-a)) * b; }
                u32x4 w; w.x = cvt_pk_bf16(r[0], r[1]); w.y = cvt_pk_bf16(r[2], r[3]); w.z = cvt_pk_bf16(r[4], r[5]); w.w = cvt_pk_bf16(r[6], r[7]);
                *(u32x4*)(ACT + (size_t)row * DFF + colbase) = w;
            }
    }
};

struct BatchOrder {
    int nunits, G, c;
    __host__ __device__ bool next(int i, Unit& u) const { const int L = i * G + c; if (L >= nunits) return false; u.pm = L; u.pn = L / 5; u.kt0 = 0; u.ntu = 0; return true; }
    __device__ __forceinline__ void a_ready(const Unit&) const {}
    __device__ __forceinline__ void done(const Unit&) const {}
};
struct EpiOddIn2 {
    static constexpr bool PERM = true;
    bf16_t* P; bf16_t* UC; bf16_t* A2;
    __device__ __forceinline__ void operator()(const f32x4 (&acc)[2][2][4][2], const Unit& u, int wr, int wc, int fr, int fq) const {
        const int colbase = u.pn * BM + wc * 32 + 8 * fq;
        const float sc = (u.pn >= 8 && u.pn < 14) ? 0.08838834764831845f : 1.f;
#pragma unroll
        for (int ai = 0; ai < 2; ++ai)
#pragma unroll
            for (int m = 0; m < 4; ++m) {
                const int row = u.pm * BM + ai * HALF + wr * 64 + m * 16 + fr;
                const int R = (row < NCTX) ? (row >> 4) : (row >> 4) + 240, t = row & 15;
#pragma unroll
                for (int bj = 0; bj < 2; ++bj) {
                    f32x4 v0 = acc[ai][bj][m][0] * sc, v1 = acc[ai][bj][m][1] * sc;
                    u32x4 w; w.x = cvt_pk_bf16(v0[0], v0[1]); w.y = cvt_pk_bf16(v0[2], v0[3]); w.z = cvt_pk_bf16(v1[0], v1[1]); w.w = cvt_pk_bf16(v1[2], v1[3]);
                    if (u.pn < 2) { const int ch = colbase + bj * HALF, g = ch >> 4, c0 = ch & 15;
                        *(u32x4*)(UC + ((size_t)(g * 1280 + R)) * 256 + t * 16 + c0) = w; *(u32x4*)(A2 + ((size_t)(g * 1280 + R)) * 512 + t * 16 + c0) = w; }
                    else *(u32x4*)(P + (size_t)row * LDP + (colbase - 512) + bj * HALF) = w;
                }
            }
    }
};
struct EpiS5E {
    static constexpr bool PERM = true;
    float* E;
    __device__ __forceinline__ void operator()(const f32x4 (&acc)[2][2][4][2], const Unit& u, int wr, int wc, int fr, int fq) const {
#pragma unroll
        for (int ai = 0; ai < 2; ++ai)
#pragma unroll
            for (int m = 0; m < 4; ++m) { float* ep = E + (size_t)(u.pm * BM + ai * HALF + wr * 64 + m * 16 + fr) * 256 + wc * 32 + 8 * fq;
#pragma unroll
                for (int bj = 0; bj < 2; ++bj) { *(f32x4*)(ep + bj * HALF) = acc[ai][bj][m][0]; *(f32x4*)(ep + bj * HALF + 4) = acc[ai][bj][m][1]; } }
    }
};
__device__ __forceinline__ float gelu_tanh_e(float x) { const float u = 0.7978845608028654f * (x + 0.044715f * x * x * x); const float e = __expf(2.f * u); return x * (1.f - __builtin_amdgcn_rcpf(e + 1.f)); }
struct EpiS5Y {
    static constexpr bool PERM = true;
    bf16_t* YG;
    __device__ __forceinline__ void operator()(const f32x4 (&acc)[2][2][4][2], const Unit& u, int wr, int wc, int fr, int fq) const {
        const int g = u.pn, panel = u.pm - 5 * g;
#pragma unroll
        for (int ai = 0; ai < 2; ++ai)
#pragma unroll
            for (int m = 0; m < 4; ++m) { const int Rl = panel * BM + ai * HALF + wr * 64 + m * 16 + fr;
                const bool ok = (panel != 0) || (Rl < 16); const int n0 = panel == 0 ? 16 * Rl : 16 * (Rl - 240);
#pragma unroll
                for (int bj = 0; bj < 2; ++bj) { const int t = 8 * bj + 2 * wc + (fq >> 1), c0 = 8 * (fq & 1);
                    const f32x4 v0 = acc[ai][bj][m][0], v1 = acc[ai][bj][m][1];
                    u32x4 w; w.x = cvt_pk_bf16(gelu_tanh_e(v0[0]), gelu_tanh_e(v0[1])); w.y = cvt_pk_bf16(gelu_tanh_e(v0[2]), gelu_tanh_e(v0[3]));
                    w.z = cvt_pk_bf16(gelu_tanh_e(v1[0]), gelu_tanh_e(v1[1])); w.w = cvt_pk_bf16(gelu_tanh_e(v1[2]), gelu_tanh_e(v1[3]));
                    if (ok) *(u32x4*)(YG + (size_t)(n0 + t) * 512 + g * 16 + c0) = w; } }
    }
};
struct EpiGlu {
    static constexpr bool PERM = true;
    const bf16_t* YG; bf16_t* MIXp;
    __device__ __forceinline__ void operator()(const f32x4 (&acc)[2][2][4][2], const Unit& u, int wr, int wc, int fr, int fq) const {
        const int colbase = u.pn * BM + wc * 32 + 8 * fq;
#pragma unroll
        for (int ai = 0; ai < 2; ++ai)
#pragma unroll
            for (int m = 0; m < 4; ++m) { const int row = u.pm * BM + ai * HALF + wr * 64 + m * 16 + fr;
#pragma unroll
                for (int bj = 0; bj < 2; ++bj) { const u32x4 y = *(const u32x4*)(YG + (size_t)row * 512 + colbase + bj * HALF);
                    const f32x4 v0 = acc[ai][bj][m][0], v1 = acc[ai][bj][m][1];
                    float r[8];
#pragma unroll
                    for (int e = 0; e < 4; ++e) { r[e] = __builtin_amdgcn_rcpf(1.f + __expf(-v0[e])); r[4 + e] = __builtin_amdgcn_rcpf(1.f + __expf(-v1[e])); }
                    u32x4 w;
                    w.x = cvt_pk_bf16(__uint_as_float(y.x << 16) * r[0], __uint_as_float(y.x & 0xffff0000u) * r[1]); w.y = cvt_pk_bf16(__uint_as_float(y.y << 16) * r[2], __uint_as_float(y.y & 0xffff0000u) * r[3]);
                    w.z = cvt_pk_bf16(__uint_as_float(y.z << 16) * r[4], __uint_as_float(y.z & 0xffff0000u) * r[5]); w.w = cvt_pk_bf16(__uint_as_float(y.w << 16) * r[6], __uint_as_float(y.w & 0xffff0000u) * r[7]);
                    *(u32x4*)(MIXp + (size_t)row * DM + colbase + bj * HALF) = w; } }
    }
};
}

namespace da {
constexpr int NW = 8, QBLK = 32, KVBLK = 64;
constexpr int SHM_V = KVBLK * 128 * 2, SHM_K = KVBLK * 64 * 2;
constexpr int OFF_V = 0, OFF_K = 2 * SHM_V, OFF_WS = OFF_K + 2 * SHM_K, SHM_TOTAL = OFF_WS + NW * 64 * 4;
constexpr float THRL = 8.f * LOG2E;
#define KSWZ64(row, colB) ((row) * 128 + ((colB) ^ ((((row) >> 1) & 7) << 4)))
#define SBAR() __builtin_amdgcn_sched_barrier(0)
__device__ __forceinline__ int crow(int r, int hi) { return (r & 3) + 8 * (r >> 2) + 4 * hi; }
__device__ __forceinline__ unsigned cvtpk(float lo, float hi) { unsigned r; asm volatile("v_cvt_pk_bf16_f32 %0, %1, %2" : "=v"(r) : "v"(lo), "v"(hi)); return r; }

__device__ __forceinline__ int v_st(int k, int c) { const int kk = (k & ~0xC) | ((k & 4) << 1) | ((k & 8) >> 1); return ((kk >> 3) * 4 + (c >> 5)) * 512 + ((kk & 7) * 32 + (c & 31)) * 2; }
__device__ __forceinline__ int v_rd_base(int lane) { return ((lane & 3) << 3) | (((lane >> 2) & 3) << 6) | (((lane >> 4) & 1) << 5) | (((lane >> 5) & 1) << 8); }
constexpr int v_rd_off(int d0, int ks, int half) { return d0 * 512 + ks * 4096 + half * 2048; }
template <int OFF> __device__ __forceinline__ s16x4 tr_read(int vb) {
  s16x4 r; asm volatile("ds_read_b64_tr_b16 %0, %1 offset:%2" : "=&v"(r) : "v"(vb), "i"(OFF) : "memory"); return r;
}
struct VFrag { s16x4 l0, h0, l1, h1, l2, h2, l3, h3; };
template <int D0> __device__ __forceinline__ void v_load8(VFrag& f, int vb) {
  f.l0 = tr_read<v_rd_off(D0, 0, 0)>(vb); f.h0 = tr_read<v_rd_off(D0, 0, 1)>(vb); f.l1 = tr_read<v_rd_off(D0, 1, 0)>(vb); f.h1 = tr_read<v_rd_off(D0, 1, 1)>(vb);
  f.l2 = tr_read<v_rd_off(D0, 2, 0)>(vb); f.h2 = tr_read<v_rd_off(D0, 2, 1)>(vb); f.l3 = tr_read<v_rd_off(D0, 3, 0)>(vb); f.h3 = tr_read<v_rd_off(D0, 3, 1)>(vb);
}
#define PVK(L, H) (bf16x8){L[0], L[1], L[2], L[3], H[0], H[1], H[2], H[3]}
__device__ __forceinline__ void v_mma4(f32x16& od, const VFrag& f, bf16x8 pa0, bf16x8 pa1, bf16x8 pa2, bf16x8 pa3) {
  od = __builtin_amdgcn_mfma_f32_32x32x16_bf16(pa0, PVK(f.l0, f.h0), od, 0, 0, 0);
  od = __builtin_amdgcn_mfma_f32_32x32x16_bf16(pa1, PVK(f.l1, f.h1), od, 0, 0, 0);
  od = __builtin_amdgcn_mfma_f32_32x32x16_bf16(pa2, PVK(f.l2, f.h2), od, 0, 0, 0);
  od = __builtin_amdgcn_mfma_f32_32x32x16_bf16(pa3, PVK(f.l3, f.h3), od, 0, 0, 0);
}
__device__ __forceinline__ void pv_d0(f32x16* o, int vb, bf16x8 pa0, bf16x8 pa1, bf16x8 pa2, bf16x8 pa3) {
  VFrag fa, fb;
  v_load8<0>(fa, vb); v_load8<1>(fb, vb);
  asm volatile("s_waitcnt lgkmcnt(8)" ::: "memory"); SBAR();
  v_mma4(o[0], fa, pa0, pa1, pa2, pa3); SBAR();
  v_load8<2>(fa, vb);
  asm volatile("s_waitcnt lgkmcnt(8)" ::: "memory"); SBAR();
  v_mma4(o[1], fb, pa0, pa1, pa2, pa3); SBAR();
  v_load8<3>(fb, vb);
  asm volatile("s_waitcnt lgkmcnt(8)" ::: "memory"); SBAR();
  v_mma4(o[2], fa, pa0, pa1, pa2, pa3);
  asm volatile("s_waitcnt lgkmcnt(0)" ::: "memory"); SBAR();
  v_mma4(o[3], fb, pa0, pa1, pa2, pa3);
}

#define EX4(B_) do { px[(B_)] = __builtin_amdgcn_exp2f(px[(B_)]); px[(B_) + 1] = __builtin_amdgcn_exp2f(px[(B_) + 1]); px[(B_) + 2] = __builtin_amdgcn_exp2f(px[(B_) + 2]); px[(B_) + 3] = __builtin_amdgcn_exp2f(px[(B_) + 3]); } while (0)
__device__ __forceinline__ void pv_d0e(f32x16* o, int vb, bf16x8 pa0, bf16x8 pa1, bf16x8 pa2, bf16x8 pa3, f32x16& px) {
  VFrag fa, fb;
  v_load8<0>(fa, vb); v_load8<1>(fb, vb);
  asm volatile("s_waitcnt lgkmcnt(8)" ::: "memory"); SBAR();
  v_mma4(o[0], fa, pa0, pa1, pa2, pa3); EX4(0); SBAR();
  v_load8<2>(fa, vb);
  asm volatile("s_waitcnt lgkmcnt(8)" ::: "memory"); SBAR();
  v_mma4(o[1], fb, pa0, pa1, pa2, pa3); EX4(4); SBAR();
  v_load8<3>(fb, vb);
  asm volatile("s_waitcnt lgkmcnt(8)" ::: "memory"); SBAR();
  v_mma4(o[2], fa, pa0, pa1, pa2, pa3); EX4(8);
  asm volatile("s_waitcnt lgkmcnt(0)" ::: "memory"); SBAR();
  v_mma4(o[3], fb, pa0, pa1, pa2, pa3); EX4(12);
}
#undef EX4
typedef __bf16 bf16x2_t __attribute__((ext_vector_type(2)));
__device__ __forceinline__ float dot2sq(unsigned w, float c) { const bf16x2_t v = __builtin_bit_cast(bf16x2_t, w); return __builtin_amdgcn_fdot2_f32_bf16(v, v, c, false); }
__device__ __forceinline__ void expA(f32x16& p0) {
#pragma unroll
  for (int r = 0; r < 16; ++r) p0[r] = __builtin_amdgcn_exp2f(p0[r]);
}
__device__ __forceinline__ unsigned cvtpk_b(float lo, float hi) { const f32x2 v = {lo, hi}; const bf16x2_t b = __builtin_convertvector(v, bf16x2_t); return __builtin_bit_cast(unsigned, b); }
__device__ __forceinline__ void finishB(f32x16& p0, f32x16& p1, float& l_reg, bf16x8& pa0, bf16x8& pa1, bf16x8& pa2, bf16x8& pa3) {
#pragma unroll
  for (int r = 0; r < 16; ++r) p1[r] = __builtin_amdgcn_exp2f(p1[r]);
  float ps = 0;
#pragma unroll
  for (int r = 0; r < 16; ++r) ps += p0[r];
#pragma unroll
  for (int r = 0; r < 16; ++r) ps += p1[r];
  { auto rr = __builtin_amdgcn_permlane32_swap(__float_as_uint(ps), __float_as_uint(ps), false, false);
    ps = __uint_as_float(rr[0]) + __uint_as_float(rr[1]); }
  l_reg += ps;
#define PK4(P, BASE, OUT) do { unsigned a0 = cvtpk_b(P[BASE + 0], P[BASE + 1]), a1 = cvtpk_b(P[BASE + 2], P[BASE + 3]);   \
    unsigned b0 = cvtpk_b(P[BASE + 4], P[BASE + 5]), b1 = cvtpk_b(P[BASE + 6], P[BASE + 7]);                              \
    auto r0 = __builtin_amdgcn_permlane32_swap(a0, b0, false, false); auto r1 = __builtin_amdgcn_permlane32_swap(a1, b1, false, false); \
    u32x4 w = {r0[0], r1[0], r0[1], r1[1]}; OUT = *reinterpret_cast<bf16x8*>(&w); } while (0)
  PK4(p0, 0, pa0); PK4(p0, 8, pa1); PK4(p1, 0, pa2); PK4(p1, 8, pa3);
#undef PK4
}
__device__ __forceinline__ void k_pre(bf16x8 (&kf)[8], const char* Ks, int r32, int hi) {
#pragma unroll
  for (int d0 = 0; d0 < 4; ++d0) { const int cb = (d0 * 16 + hi * 8) * 2;
    kf[2 * d0] = *reinterpret_cast<const bf16x8*>(Ks + KSWZ64(r32, cb)); kf[2 * d0 + 1] = *reinterpret_cast<const bf16x8*>(Ks + KSWZ64(32 + r32, cb)); }
}
__device__ __forceinline__ void qkt_k(f32x16& p0, f32x16& p1, const f32x16& pinit, const bf16x8 (&kf)[8], const bf16x8* qr) {
  p0 = pinit; p1 = pinit;
#pragma unroll
  for (int d0 = 0; d0 < 4; ++d0) { p0 = __builtin_amdgcn_mfma_f32_32x32x16_bf16(kf[2 * d0], qr[d0], p0, 0, 0, 0); p1 = __builtin_amdgcn_mfma_f32_32x32x16_bf16(kf[2 * d0 + 1], qr[d0], p1, 0, 0, 0); }
}
__device__ __forceinline__ void qkt_i(f32x16& p0, f32x16& p1, const f32x16& pinit, const char* Ks, const bf16x8* qr, int r32, int hi) {
  p0 = pinit; p1 = pinit;
#pragma unroll
  for (int d0 = 0; d0 < 4; ++d0) { const int cb = (d0 * 16 + hi * 8) * 2;
    bf16x8 b0 = *reinterpret_cast<const bf16x8*>(Ks + KSWZ64(r32, cb));
    bf16x8 b1 = *reinterpret_cast<const bf16x8*>(Ks + KSWZ64(32 + r32, cb));
    p0 = __builtin_amdgcn_mfma_f32_32x32x16_bf16(b0, qr[d0], p0, 0, 0, 0);
    p1 = __builtin_amdgcn_mfma_f32_32x32x16_bf16(b1, qr[d0], p1, 0, 0, 0); }
}
__device__ __forceinline__ void attn_comp(const bf16_t* __restrict__ Qb, const bf16_t* __restrict__ Kh, const bf16_t* __restrict__ Vh, int seq, float kmx, char* lds, f32x16 (&o)[4], const int wv) {
  const int tid = wv * 64 + lane_now();
  const int wid = tid >> 6, lane = tid & 63, r32 = lane & 31, hi = lane >> 5;
  char* V_lds = lds + OFF_V; char* K_lds = lds + OFF_K;
  float* wsb = (float*)(lds + OFF_WS); float* li_l = wsb + wid * 64;
  float l_reg = 0; bf16x8 qr[4];
#pragma unroll
  for (int d = 0; d < 4; ++d) o[d] = f32x16{};
  const bf16_t* Qw = Qb + (long)(wid * QBLK + r32) * LDP + hi * 8;
#pragma unroll
  for (int d0 = 0; d0 < 4; ++d0) qr[d0] = *reinterpret_cast<const bf16x8*>(Qw + d0 * 16);
  float qsq = 0.f;
#pragma unroll
  for (int d0 = 0; d0 < 4; ++d0) { const u32x4 w = *reinterpret_cast<const u32x4*>(&qr[d0]); qsq = dot2sq(w.x, qsq); qsq = dot2sq(w.y, qsq); qsq = dot2sq(w.z, qsq); qsq = dot2sq(w.w, qsq); }
  { auto rr = __builtin_amdgcn_permlane32_swap(__float_as_uint(qsq), __float_as_uint(qsq), false, false); qsq = __uint_as_float(rr[0]) + __uint_as_float(rr[1]); }
  const int sr = tid >> 4, sc = (tid & 15) * 8, vst0 = v_st(sr, sc), vst1 = v_st(32 + sr, sc);
  const int kr = tid >> 3, kc = (tid & 7) * 8, kst = KSWZ64(kr, kc * 2);
  const int vb0 = (int)(uintptr_t)V_lds + v_rd_base(lane);
  struct { bf16x8 vs0, vs1, ks0; } sr_[1];
#define SLOAD(i, k0) do { sr_[i].vs0 = *reinterpret_cast<const bf16x8*>(&Vh[(long)((k0) + sr) * LDP + sc]); sr_[i].vs1 = *reinterpret_cast<const bf16x8*>(&Vh[(long)((k0) + 32 + sr) * LDP + sc]); \
    sr_[i].ks0 = *reinterpret_cast<const bf16x8*>(&Kh[(long)((k0) + kr) * LDP + kc]); } while (0)
#define SWRITE(b, i) do { *(bf16x8*)(V_lds + (b) * SHM_V + vst0) = sr_[i].vs0; *(bf16x8*)(V_lds + (b) * SHM_V + vst1) = sr_[i].vs1; \
    *(bf16x8*)(K_lds + (b) * SHM_K + kst) = sr_[i].ks0; } while (0)
#define SWAIT() asm volatile("s_waitcnt vmcnt(0)" ::: "memory")
  f32x16 pA0, pA1, pB0, pB1; bf16x8 pa0, pa1, pa2, pa3; const int NTL = seq / KVBLK;
  SLOAD(0, 0); asm volatile("s_waitcnt vmcnt(0)" ::: "memory"); SWRITE(0, 0); __syncthreads();
  const float mrow = sqrtf(qsq * kmx) * 1.01f;
  f32x16 pinit;
#pragma unroll
  for (int r = 0; r < 16; ++r) pinit[r] = -mrow;
  SLOAD(0, KVBLK);
  qkt_i(pA0, pA1, pinit, K_lds, qr, r32, hi); expA(pA0);
  SWAIT(); SWRITE(1, 0); __syncthreads();
  for (int j = 1; j + 1 < NTL; j += 2) {
    SLOAD(0, (j + 1) * KVBLK);
    { bf16x8 kf[8]; SBAR(); k_pre(kf, K_lds + SHM_K, r32, hi); SBAR(); qkt_k(pB0, pB1, pinit, kf, qr);
    finishB(pA0, pA1, l_reg, pa0, pa1, pa2, pa3); SBAR(); }
    pv_d0e(o, vb0, pa0, pa1, pa2, pa3, pB0);
    __syncthreads(); SWAIT(); SWRITE(0, 0);
    __syncthreads();
    SLOAD(0, (j + 2) * KVBLK);
    { bf16x8 kf[8]; SBAR(); k_pre(kf, K_lds, r32, hi); SBAR(); qkt_k(pA0, pA1, pinit, kf, qr);
    finishB(pB0, pB1, l_reg, pa0, pa1, pa2, pa3); SBAR(); }
    pv_d0e(o, vb0 + SHM_V, pa0, pa1, pa2, pa3, pA0);
    __syncthreads(); SWAIT(); SWRITE(1, 0);
    __syncthreads();
  }
  SBAR(); qkt_i(pB0, pB1, pinit, K_lds + SHM_K, qr, r32, hi);
  finishB(pA0, pA1, l_reg, pa0, pa1, pa2, pa3); SBAR();
  pv_d0e(o, vb0, pa0, pa1, pa2, pa3, pB0);
  __syncthreads();
  finishB(pB0, pB1, l_reg, pa0, pa1, pa2, pa3); SBAR();
  pv_d0(o, vb0 + SHM_V, pa0, pa1, pa2, pa3);
  if (hi == 0) li_l[r32] = l_reg; asm volatile("s_waitcnt lgkmcnt(0)" ::: "memory");
#pragma unroll
  for (int r = 0; r < 16; ++r) { const float rl = __builtin_amdgcn_rcpf(li_l[crow(r, hi)]);
#pragma unroll
    for (int d0 = 0; d0 < 4; ++d0) o[d0][r] *= rl; }
  __syncthreads();
#undef SLOAD
#undef SWRITE
#undef SWAIT
}

__device__ __forceinline__ void diff_unit(const bf16_t* __restrict__ PROJ, int h, int row0, int seq, float kmx0, float kmx1, float lam, float omli, const float* __restrict__ subln,
                                          float* __restrict__ O1, bf16_t* __restrict__ MIX, char* lds, const int wv) {
  const int tid = wv * 64 + lane_now();
  const int wid = tid >> 6, lane = tid & 63, r32 = lane & 31, hi = lane >> 5;
  f32x16 o[4];
  attn_comp(PROJ + (size_t)row0 * LDP + h * 128, PROJ + 1024 + h * 128, PROJ + 2048 + h * 128, seq, kmx0, lds, o, wv);
  float* O1w = O1 + (size_t)(row0 + wid * QBLK) * 1024 + h * 128 + r32;
#pragma unroll
  for (int r = 0; r < 16; ++r) { const int orow = crow(r, hi);
#pragma unroll
    for (int d0 = 0; d0 < 4; ++d0) O1w[(size_t)orow * 1024 + d0 * 32] = o[d0][r]; }
  attn_comp(PROJ + (size_t)row0 * LDP + h * 128 + 64, PROJ + 1024 + h * 128 + 64, PROJ + 2048 + h * 128, seq, kmx1, lds, o, wv);
  float sw[4];
#pragma unroll
  for (int d0 = 0; d0 < 4; ++d0) sw[d0] = subln[d0 * 32 + r32] * omli;
  bf16_t* Mw = MIX + (size_t)(row0 + wid * QBLK) * DM + h * 128 + r32;
#pragma unroll
  for (int r = 0; r < 16; ++r) { const int orow = crow(r, hi);
    float v[4]; float ss = 0.f;
#pragma unroll
    for (int d0 = 0; d0 < 4; ++d0) { v[d0] = O1w[(size_t)orow * 1024 + d0 * 32] - lam * o[d0][r]; ss += v[d0] * v[d0]; }
    ss = half_sum32(ss);
    const float rs = rsqrtf(ss * (1.f / 128.f) + EPS);
#pragma unroll
    for (int d0 = 0; d0 < 4; ++d0) { const unsigned pk = cvtpk(v[d0] * rs * sw[d0], 0.f); Mw[(size_t)orow * DM + d0 * 32] = (bf16_t)(pk & 0xffffu); }
  }
}
}


namespace rt {
using da::crow; using da::cvtpk; using da::v_st; using da::v_rd_base; using da::pv_d0;
#define KSWZ128(row, colB) ((row) * 256 + ((colB) ^ (((row) & 7) << 4)))
constexpr int NCH = 65;
__device__ __forceinline__ s16x4 tr_read_a(int addr) { s16x4 r; asm volatile("ds_read_b64_tr_b16 %0, %1" : "=&v"(r) : "v"(addr) : "memory"); return r; }
#define RT_PK(L, H) (bf16x8){L[0], L[1], L[2], L[3], H[0], H[1], H[2], H[3]}
__device__ __forceinline__ void kv_unit(const bf16_t* __restrict__ PROJ, int h, int k, float lg2f, float lg2r, h16* __restrict__ KV, char* lds, const int wv) {
  const int tid = wv * 64 + lane_now();
  const int wid = tid >> 6, lane = tid & 63, r32 = lane & 31, hi = lane >> 5;
  const int row0 = 256 * k;
  {
    bf16x8 rg[16];
#pragma unroll
    for (int half = 0; half < 2; ++half)
#pragma unroll
      for (int i = 0; i < 8; ++i) { const int p = tid + 512 * i, tok = p >> 4, c8 = (p & 15) * 8;
        rg[half * 8 + i] = *reinterpret_cast<const bf16x8*>(PROJ + (size_t)(row0 + tok) * LDP + (half ? 3072 : 1536) + h * 128 + c8); }
#pragma unroll
    for (int half = 0; half < 2; ++half)
#pragma unroll
      for (int i = 0; i < 8; ++i) { const int p = tid + 512 * i, tok = p >> 4, c8 = (p & 15) * 8;
        *(bf16x8*)(lds + half * 65536 + (tok >> 6) * 16384 + v_st(tok & 63, c8)) = rg[half * 8 + i]; }
  }
  __syncthreads();
  const int dir = wid >> 2, D0a = wid & 3;
  const float lg2 = dir ? lg2r : lg2f;
  f32x16 acc[4];
#pragma unroll
  for (int d = 0; d < 4; ++d) acc[d] = f32x16{};
  const int kb = (int)(uintptr_t)lds + v_rd_base(lane) + D0a * 512, vb = (int)(uintptr_t)lds + 65536 + v_rd_base(lane);
#pragma unroll
  for (int t = 0; t < 4; ++t)
#pragma unroll
    for (int ks = 0; ks < 4; ++ks) {
      const s16x4 kl = tr_read_a(kb + t * 16384 + ks * 4096), kh = tr_read_a(kb + t * 16384 + ks * 4096 + 2048);
      s16x4 vl[4], vh[4];
#pragma unroll
      for (int d0 = 0; d0 < 4; ++d0) { vl[d0] = tr_read_a(vb + t * 16384 + ks * 4096 + d0 * 512); vh[d0] = tr_read_a(vb + t * 16384 + ks * 4096 + d0 * 512 + 2048); }
      asm volatile("s_waitcnt lgkmcnt(0)" ::: "memory"); __builtin_amdgcn_sched_barrier(0);
      const int tok0 = 64 * t + 16 * ks + 8 * hi;
      float w[8];
#pragma unroll
      for (int j = 0; j < 8; ++j) { const int e = dir ? (tok0 + j) : (255 - tok0 - j); w[j] = __builtin_amdgcn_exp2f(lg2 * (float)e); }
      u32x4 aw;
      aw.x = cvtpk(bf2f((unsigned short)kl[0]) * w[0], bf2f((unsigned short)kl[1]) * w[1]); aw.y = cvtpk(bf2f((unsigned short)kl[2]) * w[2], bf2f((unsigned short)kl[3]) * w[3]);
      aw.z = cvtpk(bf2f((unsigned short)kh[0]) * w[4], bf2f((unsigned short)kh[1]) * w[5]); aw.w = cvtpk(bf2f((unsigned short)kh[2]) * w[6], bf2f((unsigned short)kh[3]) * w[7]);
      const bf16x8 af = *reinterpret_cast<bf16x8*>(&aw);
#pragma unroll
      for (int d0 = 0; d0 < 4; ++d0) acc[d0] = __builtin_amdgcn_mfma_f32_32x32x16_bf16(af, RT_PK(vl[d0], vh[d0]), acc[d0], 0, 0, 0);
    }
  h16* out = KV + ((size_t)(dir * 12 + h) * NCH + k) * 16384 + (size_t)(32 * D0a) * 128 + r32;
#pragma unroll
  for (int r = 0; r < 16; ++r)
#pragma unroll
    for (int d0 = 0; d0 < 4; ++d0) out[(size_t)crow(r, hi) * 128 + d0 * 32] = (h16)acc[d0][r];
  __syncthreads();
}
__device__ __forceinline__ void qkt128(f32x16& p0, f32x16& p1, const char* Ks, const bf16x8* qr, int r32, int hi) {
  p0 = f32x16{}; p1 = f32x16{};
#pragma unroll
  for (int d0 = 0; d0 < 8; ++d0) { const int cb = (d0 * 16 + hi * 8) * 2;
    bf16x8 b0 = *reinterpret_cast<const bf16x8*>(Ks + KSWZ128(r32, cb));
    bf16x8 b1 = *reinterpret_cast<const bf16x8*>(Ks + KSWZ128(32 + r32, cb));
    p0 = __builtin_amdgcn_mfma_f32_32x32x16_bf16(b0, qr[d0], p0, 0, 0, 0);
    p1 = __builtin_amdgcn_mfma_f32_32x32x16_bf16(b1, qr[d0], p1, 0, 0, 0); }
}
__device__ __forceinline__ void p_to_frag(const f32x16& p0, const f32x16& p1, bf16x8& pa0, bf16x8& pa1, bf16x8& pa2, bf16x8& pa3) {
#define PK4(P, BASE, OUT) do { unsigned a0 = cvtpk(P[BASE + 0], P[BASE + 1]), a1 = cvtpk(P[BASE + 2], P[BASE + 3]);   \
    unsigned b0 = cvtpk(P[BASE + 4], P[BASE + 5]), b1 = cvtpk(P[BASE + 6], P[BASE + 7]);                              \
    auto r0 = __builtin_amdgcn_permlane32_swap(a0, b0, false, false); auto r1 = __builtin_amdgcn_permlane32_swap(a1, b1, false, false); \
    u32x4 w = {r0[0], r1[0], r0[1], r1[1]}; OUT = *reinterpret_cast<bf16x8*>(&w); } while (0)
  PK4(p0, 0, pa0); PK4(p0, 8, pa1); PK4(p1, 0, pa2); PK4(p1, 8, pa3);
#undef PK4
}
__device__ __forceinline__ void ret_tile(f32x16 (&o)[4], const char* Kt, int vb, const bf16x8* qr, int t, int wid, int r32, int hi, float lg2f, float lg2r) {
  f32x16 p0, p1;
  qkt128(p0, p1, Kt, qr, r32, hi);
  const int i = wid * 32 + r32;
#pragma unroll
  for (int r = 0; r < 16; ++r) {
    const int j0 = 64 * t + crow(r, hi), d0_ = i - j0, d1_ = d0_ - 32;
    const float w0 = d0_ > 0 ? __builtin_amdgcn_exp2f(lg2f * (float)d0_) : (d0_ < 0 ? __builtin_amdgcn_exp2f(lg2r * (float)(-d0_)) : 2.f);
    const float w1 = d1_ > 0 ? __builtin_amdgcn_exp2f(lg2f * (float)d1_) : (d1_ < 0 ? __builtin_amdgcn_exp2f(lg2r * (float)(-d1_)) : 2.f);
    p0[r] *= w0; p1[r] *= w1; }
  bf16x8 pa0, pa1, pa2, pa3;
  p_to_frag(p0, p1, pa0, pa1, pa2, pa3);
  pv_d0(o, vb, pa0, pa1, pa2, pa3);
}
__device__ __forceinline__ void out_unit(const bf16_t* __restrict__ PROJ, int h, int k, float lg2f, float lg2r, const bf16_t* __restrict__ SIN, bf16_t* __restrict__ MIX, char* lds, const int wv) {
  const int tid = wv * 64 + lane_now();
  const int wid = tid >> 6, lane = tid & 63, r32 = lane & 31, hi = lane >> 5;
  const int row0 = 256 * k;
  const int sr = tid >> 4, sc8 = (tid & 15) * 8;
  const bf16_t* Kg = PROJ + (size_t)row0 * LDP + 1536 + h * 128 + sc8; const bf16_t* Vg = PROJ + (size_t)row0 * LDP + 3072 + h * 128 + sc8;
  bf16x8 rs[8], rk[8];
  if (k > 0) {
#pragma unroll
    for (int dir = 0; dir < 2; ++dir) { const bf16_t* Sg = SIN + ((size_t)(dir * 12 + h) * NCH + k) * 16384;
#pragma unroll
      for (int i = 0; i < 4; ++i) { const int p = tid + 512 * i; rs[dir * 4 + i] = *reinterpret_cast<const bf16x8*>(Sg + (size_t)(p >> 4) * 128 + (p & 15) * 8); } }
  }
#pragma unroll
  for (int t = 0; t < 2; ++t) { rk[t * 4 + 0] = *reinterpret_cast<const bf16x8*>(Kg + (size_t)(64 * t + sr) * LDP); rk[t * 4 + 1] = *reinterpret_cast<const bf16x8*>(Kg + (size_t)(64 * t + 32 + sr) * LDP);
    rk[t * 4 + 2] = *reinterpret_cast<const bf16x8*>(Vg + (size_t)(64 * t + sr) * LDP); rk[t * 4 + 3] = *reinterpret_cast<const bf16x8*>(Vg + (size_t)(64 * t + 32 + sr) * LDP); }
  bf16x8 qr[8];
  { const bf16_t* Qw = PROJ + (size_t)(row0 + wid * 32 + r32) * LDP + h * 128 + hi * 8;
#pragma unroll
    for (int d0 = 0; d0 < 8; ++d0) qr[d0] = *reinterpret_cast<const bf16x8*>(Qw + d0 * 16); }
  if (k > 0) {
#pragma unroll
    for (int dir = 0; dir < 2; ++dir)
#pragma unroll
      for (int i = 0; i < 4; ++i) { const int p = tid + 512 * i, srow = p >> 4, c8 = (p & 15) * 8; *(bf16x8*)(lds + dir * 32768 + (srow >> 6) * 16384 + v_st(srow & 63, c8)) = rs[dir * 4 + i]; }
  }
#pragma unroll
  for (int t = 0; t < 2; ++t) { char* B = lds + 65536 + t * 32768;
    *(bf16x8*)(B + KSWZ128(sr, sc8 * 2)) = rk[t * 4 + 0]; *(bf16x8*)(B + KSWZ128(32 + sr, sc8 * 2)) = rk[t * 4 + 1];
    *(bf16x8*)(B + 16384 + v_st(sr, sc8)) = rk[t * 4 + 2]; *(bf16x8*)(B + 16384 + v_st(32 + sr, sc8)) = rk[t * 4 + 3]; }
  __syncthreads();
#pragma unroll
  for (int t = 0; t < 2; ++t) { rk[t * 4 + 0] = *reinterpret_cast<const bf16x8*>(Kg + (size_t)(128 + 64 * t + sr) * LDP); rk[t * 4 + 1] = *reinterpret_cast<const bf16x8*>(Kg + (size_t)(128 + 64 * t + 32 + sr) * LDP);
    rk[t * 4 + 2] = *reinterpret_cast<const bf16x8*>(Vg + (size_t)(128 + 64 * t + sr) * LDP); rk[t * 4 + 3] = *reinterpret_cast<const bf16x8*>(Vg + (size_t)(128 + 64 * t + 32 + sr) * LDP); }
  f32x16 o[4];
#pragma unroll
  for (int d = 0; d < 4; ++d) o[d] = f32x16{};
  const int vb0 = (int)(uintptr_t)lds + v_rd_base(lane);
  if (k > 0) {
#pragma unroll 1
    for (int dir = 0; dir < 2; ++dir) {
      const float lg2 = dir ? lg2r : lg2f; const int i = wid * 32 + r32;
      const float sc = __builtin_amdgcn_exp2f(lg2 * (float)(dir ? (256 - i) : (i + 1)));
      bf16x8 qs[8];
#pragma unroll
      for (int d0 = 0; d0 < 8; ++d0) { const u32x4 w = *reinterpret_cast<const u32x4*>(&qr[d0]); u32x4 z;
        z.x = cvtpk(__uint_as_float(w.x << 16) * sc, __uint_as_float(w.x & 0xffff0000u) * sc); z.y = cvtpk(__uint_as_float(w.y << 16) * sc, __uint_as_float(w.y & 0xffff0000u) * sc);
        z.z = cvtpk(__uint_as_float(w.z << 16) * sc, __uint_as_float(w.z & 0xffff0000u) * sc); z.w = cvtpk(__uint_as_float(w.w << 16) * sc, __uint_as_float(w.w & 0xffff0000u) * sc);
        qs[d0] = *reinterpret_cast<bf16x8*>(&z); }
      pv_d0(o, vb0 + dir * 32768, qs[0], qs[1], qs[2], qs[3]);
      pv_d0(o, vb0 + dir * 32768 + 16384, qs[4], qs[5], qs[6], qs[7]);
    }
  }
  __syncthreads();
#pragma unroll
  for (int t = 0; t < 2; ++t) { char* B = lds + t * 32768;
    *(bf16x8*)(B + KSWZ128(sr, sc8 * 2)) = rk[t * 4 + 0]; *(bf16x8*)(B + KSWZ128(32 + sr, sc8 * 2)) = rk[t * 4 + 1];
    *(bf16x8*)(B + 16384 + v_st(sr, sc8)) = rk[t * 4 + 2]; *(bf16x8*)(B + 16384 + v_st(32 + sr, sc8)) = rk[t * 4 + 3]; }
  ret_tile(o, lds + 65536, vb0 + 65536 + 16384, qr, 0, wid, r32, hi, lg2f, lg2r);
  ret_tile(o, lds + 98304, vb0 + 98304 + 16384, qr, 1, wid, r32, hi, lg2f, lg2r);
  __syncthreads();
  ret_tile(o, lds, vb0 + 16384, qr, 2, wid, r32, hi, lg2f, lg2r);
  ret_tile(o, lds + 32768, vb0 + 32768 + 16384, qr, 3, wid, r32, hi, lg2f, lg2r);
  char* Wt = lds + 65536 + wid * 8192;
  u32x4 gv[8];
#pragma unroll
  for (int i = 0; i < 8; ++i) { const int id = lane + 64 * i; gv[i] = *(const u32x4*)(PROJ + (size_t)(row0 + wid * 32 + (id >> 4)) * LDP + 4608 + h * 128 + (id & 15) * 8); }
#pragma unroll
  for (int r = 0; r < 16; ++r) { const int orow = crow(r, hi);
    float ss = 0.f;
#pragma unroll
    for (int d0 = 0; d0 < 4; ++d0) ss += o[d0][r] * o[d0][r];
    ss = half_sum32(ss);
    const float rs_ = rsqrtf(ss * (1.f / 128.f) + EPS);
#pragma unroll
    for (int d0 = 0; d0 < 4; ++d0) { const unsigned pk = cvtpk(o[d0][r] * rs_, 0.f); *(bf16_t*)(Wt + orow * 256 + (d0 * 32 + r32) * 2) = (bf16_t)(pk & 0xffffu); } }
  asm volatile("s_waitcnt lgkmcnt(0)" ::: "memory"); __builtin_amdgcn_wave_barrier();
#pragma unroll
  for (int i = 0; i < 8; ++i) { const int id = lane + 64 * i, row = id >> 4, c8 = (id & 15) * 8;
    const u32x4 y = *(const u32x4*)(Wt + row * 256 + c8 * 2);
    const size_t grow = (size_t)(row0 + wid * 32 + row);
    const u32x4 g = gv[i];
    u32x4 w;
#define SILUQ(x_) ((x_) * __builtin_amdgcn_rcpf(1.f + __expf(-(x_))))
#define GATE2(Y, G) cvtpk(__uint_as_float((Y) << 16) * SILUQ(__uint_as_float((G) << 16)), __uint_as_float((Y) & 0xffff0000u) * SILUQ(__uint_as_float((G) & 0xffff0000u)))
    w.x = GATE2(y.x, g.x); w.y = GATE2(y.y, g.y); w.z = GATE2(y.z, g.z); w.w = GATE2(y.w, g.w);
#undef GATE2
#undef SILUQ
    *(u32x4*)(MIX + grow * DM + 512 + h * 128 + c8) = w; }
  __syncthreads();
}
__device__ __forceinline__ void na_unit(const bf16_t* __restrict__ PROJ, int h, int qb, const float* __restrict__ rpb_h, bf16_t* __restrict__ MIX, char* lds, const int wv) {
  const int tid = wv * 64 + lane_now();
  const int wid = tid >> 6, lane = tid & 63, r32 = lane & 31, hi = lane >> 5;
  const bool lat = qb >= 0;
  const int row0 = lat ? NCTX + 256 * qb : 0;
  float* wsl = (float*)(lds + 32768) + wid * 64; float* al_l = wsl; float* li_l = wsl + 32;
  float* rpbL = (float*)(lds + 32768 + 2048);
  if (lat && tid < 480) { const int dr = tid >> 5, dc = tid & 31; rpbL[tid] = dc < 31 ? rpb_h[dr * 31 + dc] * LOG2E : 0.f; }
  bf16x8 qr[8];
  { const bf16_t* Qw = PROJ + (size_t)(row0 + wid * 32 + r32) * LDP + 3072 + h * 128 + hi * 8;
#pragma unroll
    for (int d0 = 0; d0 < 8; ++d0) qr[d0] = *reinterpret_cast<const bf16x8*>(Qw + d0 * 16); }
  const int qrow = 4 * qb + (wid >> 1), jq = 32 * (wid & 1) + r32;
  const int r0q = min(max(qrow - 4, 0), 248), c0 = min(max(jq - 8, 0), 48), R0 = min(max(4 * qb - 4, 0), 244);
  const int ntile = lat ? 16 : 4, nloc = lat ? 12 : 0;
  f32x16 o[4];
#pragma unroll
  for (int d = 0; d < 4; ++d) o[d] = f32x16{};
  float m_reg = -1e30f, l_reg = 0.f;
  const int vb0 = (int)(uintptr_t)lds + v_rd_base(lane);
  const int sr = tid >> 4, sc8 = (tid & 15) * 8;
  bf16x8 k0, k1, v0, v1;
#define NA_LOAD(tile_) do { const bool lc_ = (tile_) < nloc; const int krow0_ = lc_ ? NCTX + 64 * (R0 + (tile_)) : 64 * ((tile_) - nloc); \
    const bf16_t* Kg_ = PROJ + (size_t)krow0_ * LDP + 4096 + h * 128; const bf16_t* Vg_ = PROJ + (size_t)krow0_ * LDP + 5120 + h * 128; \
    k0 = *reinterpret_cast<const bf16x8*>(Kg_ + (size_t)sr * LDP + sc8); k1 = *reinterpret_cast<const bf16x8*>(Kg_ + (size_t)(32 + sr) * LDP + sc8); \
    v0 = *reinterpret_cast<const bf16x8*>(Vg_ + (size_t)sr * LDP + sc8); v1 = *reinterpret_cast<const bf16x8*>(Vg_ + (size_t)(32 + sr) * LDP + sc8); } while (0)
  NA_LOAD(0);
#pragma unroll 1
  for (int tile = 0; tile < ntile; ++tile) {
    const bool local = tile < nloc; const int kr = R0 + tile;
    *(bf16x8*)(lds + KSWZ128(sr, sc8 * 2)) = k0; *(bf16x8*)(lds + KSWZ128(32 + sr, sc8 * 2)) = k1;
    *(bf16x8*)(lds + 16384 + v_st(sr, sc8)) = v0; *(bf16x8*)(lds + 16384 + v_st(32 + sr, sc8)) = v1;
    if (tile + 1 < ntile) NA_LOAD(tile + 1);
    __syncthreads();
    const bool active = !local || (kr >= r0q && kr < r0q + 8);
    if (active) {
      f32x16 p0, p1;
      qkt128(p0, p1, lds, qr, r32, hi);
      if (local) {
        const float* bl = rpbL + (kr - qrow + 7) * 32 + 15 - jq;
#pragma unroll
        for (int r = 0; r < 16; ++r) { const int j0 = crow(r, hi), j1 = j0 + 32;
          const bool ok0 = (j0 >= c0) && (j0 < c0 + 16), ok1 = (j1 >= c0) && (j1 < c0 + 16);
          const float b0 = bl[ok0 ? j0 : jq], b1 = bl[ok1 ? j1 : jq];
          p0[r] = ok0 ? p0[r] + b0 : -1e30f; p1[r] = ok1 ? p1[r] + b1 : -1e30f; }
      }
      float pmax = p0[0];
#pragma unroll
      for (int r = 1; r < 16; ++r) pmax = fmaxf(pmax, p0[r]);
#pragma unroll
      for (int r = 0; r < 16; ++r) pmax = fmaxf(pmax, p1[r]);
      { auto rr = __builtin_amdgcn_permlane32_swap(__float_as_uint(pmax), __float_as_uint(pmax), false, false); pmax = fmaxf(__uint_as_float(rr[0]), __uint_as_float(rr[1])); }
      const float mn = fmaxf(m_reg, pmax); const float alpha = __builtin_amdgcn_exp2f(m_reg - mn); m_reg = mn;
      float ps = 0.f;
#pragma unroll
      for (int r = 0; r < 16; ++r) { p0[r] = __builtin_amdgcn_exp2f(p0[r] - mn); p1[r] = __builtin_amdgcn_exp2f(p1[r] - mn); ps += p0[r] + p1[r]; }
      { auto rr = __builtin_amdgcn_permlane32_swap(__float_as_uint(ps), __float_as_uint(ps), false, false); ps = __uint_as_float(rr[0]) + __uint_as_float(rr[1]); }
      l_reg = l_reg * alpha + ps;
      if (hi == 0) al_l[r32] = alpha; asm volatile("s_waitcnt lgkmcnt(0)" ::: "memory");
#pragma unroll
      for (int r = 0; r < 16; ++r) { const float a = al_l[crow(r, hi)];
#pragma unroll
        for (int d = 0; d < 4; ++d) o[d][r] *= a; }
      bf16x8 pa0, pa1, pa2, pa3;
      p_to_frag(p0, p1, pa0, pa1, pa2, pa3);
      pv_d0(o, vb0 + 16384, pa0, pa1, pa2, pa3);
    }
    __syncthreads();
  }
#undef NA_LOAD
  if (hi == 0) li_l[r32] = l_reg; asm volatile("s_waitcnt lgkmcnt(0)" ::: "memory");
  bf16_t* Mw = MIX + (size_t)(row0 + wid * 32) * DM + 1024 + h * 128 + r32;
#pragma unroll
  for (int r = 0; r < 16; ++r) { const int orow = crow(r, hi); const float rl = __builtin_amdgcn_rcpf(li_l[orow]);
#pragma unroll
    for (int d0 = 0; d0 < 4; ++d0) { const unsigned pk = cvtpk(o[d0][r] * rl, 0.f); Mw[(size_t)orow * DM + d0 * 32] = (bf16_t)(pk & 0xffffu); } }
  __syncthreads();
}
}

#define XB_TMO      128
#define XB_XCNT(j)  (256  + 64 * (j))
#define XB_XSUB(j)  (1280 + 64 * (j))
#define XB_XGEN(j)  (2304 + 64 * (j))
#define XB_TOP      3328
#define XB_TOPGEN   3392
#define XCD_BAR_WORDS 3456
#define XB_SPIN_CAP (1u << 22)
__device__ __forceinline__ unsigned xb_ld(unsigned* p)              { return __hip_atomic_load(p, __ATOMIC_RELAXED, __HIP_MEMORY_SCOPE_AGENT); }
__device__ __forceinline__ unsigned xb_add(unsigned* p, unsigned v) { return __hip_atomic_fetch_add(p, v, __ATOMIC_RELAXED, __HIP_MEMORY_SCOPE_AGENT); }
__device__ __forceinline__ unsigned xb_xcc_id() { return (unsigned)__builtin_amdgcn_s_getreg((3 << 11) | 20) & 0xFu; }
#define XB_SPIN(cond, bar) do { unsigned _sp = 0; while (cond) { __builtin_amdgcn_s_sleep(1); \
    if ((++_sp & 255u) == 0u) { if (xb_ld(&(bar)[XB_TMO])) break; if (_sp > XB_SPIN_CAP) { atomicAdd(&(bar)[XB_TMO], 1u); break; } } } } while (0)
struct XcdBarrier { unsigned* bar; unsigned x; volatile LAS unsigned* st; };
__device__ __forceinline__ XcdBarrier xcd_barrier_post(unsigned* bar, volatile LAS unsigned* st) {
    XcdBarrier b; b.bar = bar; b.x = xb_xcc_id(); b.st = st;
    if (threadIdx.x == 0) (void)xb_add(&bar[XB_XCNT(b.x)], 1u);
    return b;
}
__device__ __forceinline__ void xcd_barrier_complete(unsigned* bar, unsigned x, unsigned& nloc, unsigned& nx) {
    const unsigned G = gridDim.x * gridDim.y * gridDim.z;
    unsigned sum, cnt, mine, sp = 0u;
    for (;;) {
        sum = 0u; cnt = 0u; mine = 0u;
#pragma unroll
        for (unsigned j = 0; j < 16; ++j) { const unsigned c = xb_ld(&bar[XB_XCNT(j)]); sum += c; cnt += (c > 0u) ? 1u : 0u; mine = (j == x) ? c : mine; }
        if (sum == G) break;
        __builtin_amdgcn_s_sleep(1);
        if ((++sp & 255u) == 0u) { if (xb_ld(&bar[XB_TMO])) break; if (sp > XB_SPIN_CAP) { atomicAdd(&bar[XB_TMO], 1u); break; } }
    }
    nloc = mine > 0u ? mine : 1u; nx = cnt > 0u ? cnt : 1u;
}
__device__ __forceinline__ void xcd_barrier(const XcdBarrier& b) {
    asm volatile("s_waitcnt vmcnt(0)" ::: "memory");
    __syncthreads();
    if (threadIdx.x == 0) {
        unsigned* bar = b.bar;
        __builtin_amdgcn_s_waitcnt(0);
        unsigned nloc = b.st[0], nx = b.st[1];
        if (nloc == 0u) { xcd_barrier_complete(bar, b.x, nloc, nx); b.st[0] = nloc; b.st[1] = nx; }
        const unsigned old = xb_add(&bar[XB_XSUB(b.x)], 1u);
        const unsigned gen = old / nloc;
        if (old + 1u == (gen + 1u) * nloc) {
            __builtin_amdgcn_fence(__ATOMIC_RELEASE, "agent");
            asm volatile("s_waitcnt vmcnt(0)" ::: "memory");
            const unsigned og = xb_add(&bar[XB_TOP], 1u);
            const unsigned tg = og / nx;
            if (og + 1u == (tg + 1u) * nx) xb_add(&bar[XB_TOPGEN], 1u);
            else XB_SPIN(xb_ld(&bar[XB_TOPGEN]) == tg, bar);
            __builtin_amdgcn_fence(__ATOMIC_ACQUIRE, "agent");
            xb_add(&bar[XB_XGEN(b.x)], 1u);
            asm volatile("s_waitcnt vmcnt(0)" ::: "memory");
        } else {
            XB_SPIN(xb_ld(&bar[XB_XGEN(b.x)]) == gen, bar);
            __builtin_amdgcn_fence(__ATOMIC_ACQUIRE, "agent");
            asm volatile("s_waitcnt vmcnt(0)" ::: "memory");
        }
    }
    __syncthreads();
}

struct Frame {
    LAS unsigned char* lds; char* ldsg;
    int wave, vcu, G, gw, NGW;
};

template <int MODE>
__device__ __forceinline__ void transpose_item(const float* __restrict__ W, int K, int N, bf16_t* __restrict__ WT, LAS float* scr, int item, int lane) {
    const int nblk = N / 32, kb = item / nblk, nb = item % nblk, k0 = 64 * kb, n0 = 32 * nb;
#pragma unroll 8
    for (int i = 0; i < 32; ++i) { const int kk = 2 * i + (lane >> 5); scr[kk * 33 + (lane & 31)] = W[(size_t)(k0 + kk) * N + n0 + (lane & 31)]; }
    LDS_WAIT(); asm volatile("" ::: "memory");
    int d0;
    if (MODE == 1) { const int half = n0 >= DFF ? 1 : 0, j0 = n0 - half * DFF; d0 = (j0 >> 7) * 256 + half * 128 + (j0 & 127); } else d0 = n0;
    const int c = lane & 7;
#pragma unroll
    for (int j = 0; j < 4; ++j) { const int n = (lane >> 3) + 8 * j; const LAS float* s = scr + (8 * c) * 33 + n;
        u32x4 o; o.x = cvt_pk_bf16(s[0 * 33], s[1 * 33]); o.y = cvt_pk_bf16(s[2 * 33], s[3 * 33]); o.z = cvt_pk_bf16(s[4 * 33], s[5 * 33]); o.w = cvt_pk_bf16(s[6 * 33], s[7 * 33]);
        *(u32x4*)(WT + (size_t)(d0 + n) * K + k0 + 8 * c) = o; }
    LDS_WAIT(); asm volatile("" ::: "memory");
}

struct Args { const float* in[31]; float* out; unsigned char* ws; int ph_lo, ph_hi, li, pad; };
enum { I_X = 0, I_C, I_CTX, I_CCTX, I_ADAW, I_ADAB, I_N1W, I_N2W, I_W13, I_W2, I_EWIN, I_EWOUT, I_LQ1, I_LK1, I_LQ2, I_LK2, I_SUBLN, I_RPB,
       I_OWIN, I_OWOUT, I_LAMRE, I_LAMIM, I_BRE, I_BIM, I_CRE, I_CIM, I_LOGSTEP, I_S5D, I_WGLU, I_DECAY, I_FNW };
constexpr int PH_PER_LAYER = 10, P_FINAL = 1 + 4 * PH_PER_LAYER, NPHASE = P_FINAL + 1;

typedef __attribute__((address_space(4))) const unsigned char* kaptr_t;
__device__ __forceinline__ const float* ldin(int i) {
    kaptr_t ka = (kaptr_t)__builtin_amdgcn_kernarg_segment_ptr();
    unsigned off = (unsigned)i * 8u; asm volatile("" : "+s"(off));
    const unsigned long long pv = *(const unsigned long long __attribute__((address_space(4)))*)(ka + off);
    return (const float*)(const GAS float*)pv;
}

constexpr int IT_IN_E = 32 * (NIN_E / 32), IT_IN_O = 32 * (NIN_O / 32), IT_OUT = 32 * 64, IT_13 = 32 * (2 * DFF / 32), IT_2 = (DFF / 64) * 64;
constexpr int IT_LAYER_E = IT_IN_E + IT_OUT + IT_13 + IT_2, IT_LAYER_O = IT_IN_O + IT_OUT + IT_13 + IT_2;
constexpr int IT_TR = 2 * IT_LAYER_E + 2 * IT_LAYER_O;
#ifndef CV_P0
#define CV_P0 61900
#endif
#ifndef CV_P1
#define CV_P1 68900
#endif
#ifndef CV_P2
#define CV_P2 75400
#endif
#ifndef CV_P3
#define CV_P3 78400
#endif
#ifndef CV_P4
#define CV_P4 84900
#endif
#ifndef CV_P5
#define CV_P5 91900
#endif
#ifndef CV_P6
#define CV_P6 98400
#endif
__device__ __forceinline__ int cv_bound(int t) { return t <= 0 ? CV_P0 : t == 1 ? CV_P1 : t == 2 ? CV_P2 : t == 3 ? CV_P3 : t == 4 ? CV_P4 : t == 5 ? CV_P5 : t == 6 ? CV_P6 : IT_TR; }
static_assert(CV_P0 >= IT_IN_E + IT_OUT, "layer 0 in/out weights are needed right after the prologue");
static_assert(CV_P1 >= IT_LAYER_E && CV_P2 >= IT_LAYER_E + IT_IN_O + IT_OUT && CV_P3 >= IT_LAYER_E + IT_LAYER_O, "conversion deadline (layers 0/1)");
static_assert(CV_P4 >= IT_LAYER_E + IT_LAYER_O + IT_IN_E + IT_OUT && CV_P5 >= 2 * IT_LAYER_E + IT_LAYER_O && CV_P6 >= 2 * IT_LAYER_E + IT_LAYER_O + IT_IN_O + IT_OUT, "conversion deadline (layers 2/3)");
static_assert(CV_P0 <= CV_P1 && CV_P1 <= CV_P2 && CV_P2 <= CV_P3 && CV_P3 <= CV_P4 && CV_P4 <= CV_P5 && CV_P5 <= CV_P6 && CV_P6 <= IT_TR, "monotone");
__device__ __forceinline__ void conv_item(int r, unsigned char* ws, LAS float* scr, int plane) {
    const int pair = r / (IT_LAYER_E + IT_LAYER_O); r -= pair * (IT_LAYER_E + IT_LAYER_O);
    int L, odd; if (r < IT_LAYER_E) { L = 2 * pair; odd = 0; } else { L = 2 * pair + 1; odd = 1; r -= IT_LAYER_E; }
    const int itin = odd ? IT_IN_O : IT_IN_E, nin = odd ? NIN_O : NIN_E;
    if (r < itin) { const float* W = odd ? ldin(I_OWIN) + (size_t)pair * DM * NIN_O : ldin(I_EWIN) + (size_t)pair * DM * NIN_E;
        transpose_item<0>(W, DM, nin, (bf16_t*)(ws + WS_WIN + (size_t)L * 26 * MiB), scr, r, plane); return; } r -= itin;
    if (r < IT_OUT) { const float* W = (odd ? ldin(I_OWOUT) : ldin(I_EWOUT)) + (size_t)pair * DM * DM;
        transpose_item<0>(W, DM, DM, (bf16_t*)(ws + WS_WOUT + (size_t)L * 8 * MiB), scr, r, plane); return; } r -= IT_OUT;
    if (r < IT_13) { transpose_item<1>(ldin(I_W13) + (size_t)L * DM * 2 * DFF, DM, 2 * DFF, (bf16_t*)(ws + WS_W13 + (size_t)L * 44 * MiB), scr, r, plane); return; } r -= IT_13;
    transpose_item<0>(ldin(I_W2) + (size_t)L * DFF * DM, DFF, DM, (bf16_t*)(ws + WS_W2 + (size_t)L * 22 * MiB), scr, r, plane);
}
__global__ void __launch_bounds__(512, 2) fwd(Args args) {
    extern __shared__ __attribute__((aligned(16))) unsigned char lds_raw[];
    Frame F;
    F.lds = (LAS unsigned char*)lds_raw; F.ldsg = (char*)lds_raw;
    F.wave = __builtin_amdgcn_readfirstlane((int)threadIdx.x >> 6);
    F.G = gridDim.x; { const int bx = blockIdx.x; F.vcu = (F.G % 8 == 0) ? (bx % 8) * (F.G / 8) + bx / 8 : bx; }
    F.gw = F.vcu * 8 + F.wave; F.NGW = F.G * 8;
    unsigned char* ws = (unsigned char*)ldin(32);
    unsigned* ctl = (unsigned*)(ws + WS_CTL);
    for (int u = threadIdx.x; u < (LDS_BYTES - LDSCTL_OFF) / 4; u += 512) ((LAS unsigned*)(F.lds + LDSCTL_OFF))[u] = 0u;
    __syncthreads();
    const int lo = args.ph_lo, hi = args.ph_hi;
    volatile LAS unsigned* MISC = (volatile LAS unsigned*)(F.lds + MISC_OFF);
    XcdBarrier bar; bar.bar = ctl + CW_BAR + args.li * BAR_STRIDE; bar.x = 0; bar.st = nullptr;
    if (hi - lo > 1) bar = xcd_barrier_post(ctl + CW_BAR + args.li * BAR_STRIDE, MISC + 8);
#define IN(k) (lo <= (k) && (k) < hi)
#define SEAM(k) do { if (IN(k) && IN((k) + 1)) xcd_barrier(bar); } while (0)

#define TAIL_CONV(nwg_, t_) do { const int nbusy_ = (nwg_) % pG; const int lo_ = cv_bound(t_), hi_ = cv_bound((t_) + 1); \
        if ((int)blockIdx.x >= nbusy_ && lo_ < hi_) { asm volatile("s_waitcnt vmcnt(0) lgkmcnt(0)" ::: "memory"); __syncthreads(); LAS float* scr_ = (LAS float*)(F.lds + pwave * 16384); const int nidle_ = pG - nbusy_; \
            for (int it = lo_ + ((int)blockIdx.x - nbusy_) * 8 + pwave; it < hi_; it += nidle_ * 8) conv_item(it, wsp, scr_, plane); } } while (0)
#define MOD ((float*)(wsp + WS_MOD))
#define ROPE ((float*)(wsp + WS_ROPE))
#define LAMV ((float*)(wsp + WS_LAM))
#define XW ((h16*)(wsp + WS_XW))
#define Hb ((bf16_t*)(wsp + WS_H))
#define PROJ ((bf16_t*)(wsp + WS_PROJ))
#define ACT ((bf16_t*)(wsp + WS_PROJ))
#define MIX ((bf16_t*)(wsp + WS_MIX))
#define Ub ((float*)(wsp + WS_U))
#define Y2 ((float*)(wsp + WS_Y2))
#define ORb ((float*)(wsp + WS_OR))
#define O1 ((float*)(wsp + WS_O1))
#define KVb ((h16*)(wsp + WS_OR))
#define SINb ((bf16_t*)(wsp + WS_OR + 100 * MiB))
#define UCb ((bf16_t*)(wsp + WS_UC))
#define A2b ((bf16_t*)(wsp + WS_A2))
#define Eb ((float*)(wsp + WS_E))
#define YGb ((bf16_t*)(wsp + WS_YG))
#define W1Tb ((bf16_t*)(wsp + WS_W1T))
#define W2Tb ((bf16_t*)(wsp + WS_W2T))
#define WGTb ((bf16_t*)(wsp + WS_WGT))
#define SLAB ((float*)(wsp + WS_O1))
#define modL (MOD + (size_t)(L * 2) * 12288)
#define PH_BEGIN unsigned long long wsi_ = (unsigned long long)ws; asm volatile("" : "+s"(wsi_)); unsigned char* wsp = (unsigned char*)(GAS unsigned char*)wsi_; \
    int pG = F.G, pvcu = F.vcu, pwave = F.wave; asm volatile("" : "+s"(pG), "+s"(pvcu), "+s"(pwave)); const int pgw = pvcu * 8 + pwave, pNGW = pG * 8; (void)pgw; (void)pNGW; \
    const int plane = lane_now(); const int ptid = pwave * 64 + plane; (void)ptid;

    if (IN(0)) { PH_BEGIN
        {
            const float* cv = ldin(I_C); const float* ccv = ldin(I_CCTX);
            LAS f32x4* red = (LAS f32x4*)F.lds;
            const int jc = ptid & 31, kq = ptid >> 5;
            for (int it = blockIdx.x; it < 4 * 96; it += pG) {
                const int L = it / 96, slab = it % 96;
                const float* W = ldin(I_ADAW) + (size_t)L * DM * 12288 + slab * 128 + 4 * jc;
                f32x4 a0 = {0.f, 0.f, 0.f, 0.f}, a1 = {0.f, 0.f, 0.f, 0.f};
#pragma unroll 8
                for (int k = kq; k < DM; k += 16) { const f32x4 w = *(const f32x4*)(W + (size_t)k * 12288); const float s0 = silu_f(cv[k]), s1 = silu_f(ccv[k]); a0 = a0 + w * s0; a1 = a1 + w * s1; }
                red[(0 * 16 + kq) * 32 + jc] = a0; red[(1 * 16 + kq) * 32 + jc] = a1;
                __syncthreads();
                if (ptid < 64) { const int which = ptid >> 5; f32x4 s = {0.f, 0.f, 0.f, 0.f};
#pragma unroll
                    for (int q = 0; q < 16; ++q) s = s + red[(which * 16 + q) * 32 + jc];
                    const f32x4 b = *(const f32x4*)(ldin(I_ADAB) + (size_t)L * 12288 + slab * 128 + 4 * jc);
                    *(f32x4*)(MOD + (size_t)(L * 2 + which) * 12288 + slab * 128 + 4 * jc) = s + b; }
                __syncthreads();
            }
        }
        {
            LAS float* k0 = (LAS float*)F.lds;
            const int b2 = ((int)blockIdx.x + pG - (128 % pG)) % pG;
            for (int it = b2; it < 64; it += pG) {
                const int jl2 = it >> 5, g = it & 31;
                {
                    const int dir = ptid >> 8, cp = (ptid >> 4) & 15, c = ptid & 15;
                    const int pg = (jl2 * 2 + dir) * 32 + g;
                    const float dt = expf(ldin(I_LOGSTEP)[pg]);
                    const float* lre = ldin(I_LAMRE) + pg * 64; const float* lim = ldin(I_LAMIM) + pg * 64;
                    const float* bre = ldin(I_BRE) + (size_t)pg * 64 * 16 + c; const float* bim = ldin(I_BIM) + (size_t)pg * 64 * 16 + c;
                    const float* cre = ldin(I_CRE) + (size_t)(pg * 16 + cp) * 64; const float* cim = ldin(I_CIM) + (size_t)(pg * 16 + cp) * 64;
                    float Kt[16];
#pragma unroll
                    for (int q = 0; q < 16; ++q) Kt[q] = 0.f;
                    for (int p = 0; p < 64; ++p) {
                        const float lr = lre[p], li = lim[p];
                        const float mag = expf(lr * dt); float sn, cs; sincosf(li * dt, &sn, &cs);
                        const float ar = mag * cs, ai = mag * sn, den = lr * lr + li * li, nr = ar - 1.f, ni = ai;
                        const float fr = (nr * lr + ni * li) / den, fi = (ni * lr - nr * li) / den;
                        const float br = bre[p * 16], bi = bim[p * 16];
                        const float bbr = fr * br - fi * bi, bbi = fr * bi + fi * br;
                        const float cr = cre[p], ci = cim[p];
                        const float zr = cr * bbr - ci * bbi, zi = cr * bbi + ci * bbr;
                        float wr_ = 1.f, wi_ = 0.f;
#pragma unroll
                        for (int q = 0; q < 16; ++q) { Kt[q] += zr * wr_ - zi * wi_; const float t2 = wr_ * ar - wi_ * ai; wi_ = wr_ * ai + wi_ * ar; wr_ = t2; }
                    }
                    k0[(dir * 16 + cp) * 16 + c] = Kt[0];
                    __syncthreads();
                    bf16_t* W2 = W2Tb + (size_t)((jl2 * 32 + g) * 256) * 512;
                    if (dir == 0) {
#pragma unroll
                        for (int q = 1; q < 16; ++q) { const bf16_t kv = (bf16_t)(cvt_pk_bf16(Kt[q], 0.f) & 0xffffu);
                            for (int sq = 0; sq + q < 16; ++sq) W2[(size_t)((sq + q) * 16 + cp) * 512 + sq * 16 + c] = kv; }
                        const float dd = (c == cp) ? ldin(I_S5D)[jl2 * 512 + g * 16 + c] : 0.f;
                        const bf16_t kd = (bf16_t)(cvt_pk_bf16(Kt[0] + k0[(16 + cp) * 16 + c] + dd, 0.f) & 0xffffu);
                        for (int t = 0; t < 16; ++t) W2[(size_t)(t * 16 + cp) * 512 + t * 16 + c] = kd;
                    } else {
#pragma unroll
                        for (int q = 1; q < 16; ++q) { const bf16_t kv = (bf16_t)(cvt_pk_bf16(Kt[q], 0.f) & 0xffffu);
                            for (int t = 0; t + q < 16; ++t) W2[(size_t)(t * 16 + cp) * 512 + (t + q) * 16 + c] = kv; }
                    }
                }
                if (ptid < 128) {
                    const int dir = ptid >> 6, p = ptid & 63;
                    const int pg = (jl2 * 2 + dir) * 32 + g;
                    const float dt = expf(ldin(I_LOGSTEP)[pg]);
                    const float lr = ldin(I_LAMRE)[pg * 64 + p], li = ldin(I_LAMIM)[pg * 64 + p];
                    const float mag = expf(lr * dt); float sn, cs; sincosf(li * dt, &sn, &cs);
                    const float ar = mag * cs, ai = mag * sn, den = lr * lr + li * li, nr = ar - 1.f, ni = ai;
                    const float fr = (nr * lr + ni * li) / den, fi = (ni * lr - nr * li) / den;
                    float pr[17], pi[17]; pr[0] = 1.f; pi[0] = 0.f;
#pragma unroll
                    for (int q = 1; q < 17; ++q) { pr[q] = pr[q - 1] * ar - pi[q - 1] * ai; pi[q] = pr[q - 1] * ai + pi[q - 1] * ar; }
                    bf16_t* W1r = W1Tb + (size_t)((jl2 * 32 + g) * 256 + dir * 128 + 2 * p) * 256;
                    const float* bre = ldin(I_BRE) + (size_t)(pg * 64 + p) * 16; const float* bim = ldin(I_BIM) + (size_t)(pg * 64 + p) * 16;
#pragma unroll
                    for (int c = 0; c < 16; ++c) { const float br = bre[c], bi = bim[c]; const float bbr = fr * br - fi * bi, bbi = fr * bi + fi * br;
#pragma unroll
                        for (int t = 0; t < 16; ++t) { const float per = dir ? pr[t] : pr[15 - t], pei = dir ? pi[t] : pi[15 - t]; const float vr = per * bbr - pei * bbi, vi = per * bbi + pei * bbr;
                            W1r[t * 16 + c] = (bf16_t)(cvt_pk_bf16(vr, 0.f) & 0xffffu); W1r[256 + t * 16 + c] = (bf16_t)(cvt_pk_bf16(vi, 0.f) & 0xffffu); } }
                    bf16_t* W2 = W2Tb + (size_t)((jl2 * 32 + g) * 256) * 512 + 256 + dir * 128 + 2 * p;
                    const float* cre = ldin(I_CRE) + (size_t)(pg * 16) * 64 + p; const float* cim = ldin(I_CIM) + (size_t)(pg * 16) * 64 + p;
#pragma unroll
                    for (int cp = 0; cp < 16; ++cp) { const float cr = cre[cp * 64], ci = cim[cp * 64];
#pragma unroll
                        for (int t = 0; t < 16; ++t) { const float per = dir ? pr[16 - t] : pr[t + 1], pei = dir ? pi[16 - t] : pi[t + 1]; const float zr = cr * per - ci * pei, zi = cr * pei + ci * per;
                            *(unsigned*)(W2 + (size_t)(t * 16 + cp) * 512) = cvt_pk_bf16(zr, -zi); } }
                }
                __syncthreads();
            }
        }
        {
            LAS float* scr = (LAS float*)(F.lds + pwave * 16384);
            constexpr int IT_ROPE = 64, IT_XW = NCTX, IT_LAM = 1, IT_WG = 2 * 128;
            constexpr int IT_ALL = CV_P0 + IT_ROPE + IT_XW + IT_LAM + IT_WG;
            for (int it = pgw; it < IT_ALL; it += pNGW) {
                int r = it;
                if (r < CV_P0) { conv_item(r, ws, scr, plane); continue; }
                r += IT_TR - CV_P0;
                r -= IT_TR;
                if (r < IT_ROPE) { const int idx = r * 64 + plane, pos = idx >> 4, f = idx & 15;
                    const float freq = powf(10000.f, -(float)f / 16.f); const float ang = (float)pos * freq; float sn, cs; sincosf(ang, &sn, &cs);
                    ROPE[idx * 2] = cs; ROPE[idx * 2 + 1] = sn; continue; }
                r -= IT_ROPE;
                if (r < IT_XW) { const float* src = ldin(I_CTX) + (size_t)r * DM;
#pragma unroll
                    for (int j = 0; j < 4; ++j) { const int c = 8 * (plane + 64 * j); st8h(XW + (size_t)r * DM + c, *(const f32x4*)(src + c), *(const f32x4*)(src + c + 4)); }
                    continue; }
                r -= IT_XW;
                if (r >= IT_LAM) { r -= IT_LAM; const int j2 = r >> 7; transpose_item<0>(ldin(I_WGLU) + (size_t)j2 * 512 * 512, 512, 512, WGTb + (size_t)j2 * 512 * 512, scr, r & 127, plane); continue; }
                {
                    for (int je = 0; je < 2; ++je) {
                        const float a = wave_sum(ldin(I_LQ1)[je * 64 + plane] * ldin(I_LK1)[je * 64 + plane]);
                        const float b = wave_sum(ldin(I_LQ2)[je * 64 + plane] * ldin(I_LK2)[je * 64 + plane]);
                        const float li = 0.8f - 0.6f * expf(-0.3f * (float)(2 * je));
                        if (plane == 0) { LAMV[je * 2] = expf(a) - expf(b) + li; LAMV[je * 2 + 1] = 1.f - li; }
                    }
                }
            }
        }
    }
    SEAM(0);

    for (int L = 0; L < 4; ++L) {
        const int pb = 1 + L * PH_PER_LAYER;
        const bool odd = (L & 1) != 0; const int jl = L >> 1;
#define NORM_LOAD(F32_, n_, r_) do { const int nl_ = min((n_), NT - 1); \
            if (F32_) { const float* p_ = xin + (size_t)(nl_ - NCTX) * DM + 8 * plane; _Pragma("unroll") for (int j = 0; j < 4; ++j) { r_[2 * j] = *(const u32x4*)(p_ + 512 * j); r_[2 * j + 1] = *(const u32x4*)(p_ + 512 * j + 4); } } \
            else { const h16* p_ = XW + (size_t)nl_ * DM + 8 * plane; _Pragma("unroll") for (int j = 0; j < 4; ++j) r_[j] = *(const u32x4*)(p_ + 512 * j); } } while (0)
#define NORM_CVT(F32_, r_, v_) do { if (F32_) { _Pragma("unroll") for (int j = 0; j < 8; ++j) v_[j] = __builtin_bit_cast(f32x4, r_[(F32_) ? j : 0]); } \
            else { _Pragma("unroll") for (int j = 0; j < 4; ++j) { const f32x8 f_ = __builtin_convertvector(__builtin_bit_cast(h16x8, r_[j]), f32x8); v_[2 * j] = (f32x4){f_[0], f_[1], f_[2], f_[3]}; v_[2 * j + 1] = (f32x4){f_[4], f_[5], f_[6], f_[7]}; } } } while (0)
#define NORM_LATENT(which, F32_) do { int n = NCTX + pgw; \
              u32x4 r1[(F32_) ? 8 : 4], r2[(F32_) ? 8 : 4]; \
              NORM_LOAD(F32_, n, r1); NORM_LOAD(F32_, n + pNGW, r2); \
              while (n < NT) { \
                f32x4 v[8]; NORM_CVT(F32_, r1, v); \
                _Pragma("unroll") for (int j = 0; j < ((F32_) ? 8 : 4); ++j) r1[j] = r2[j]; \
                NORM_LOAD(F32_, n + 2 * pNGW, r2); \
                unsigned long long mvi_ = (unsigned long long)(modL), nwi_ = (unsigned long long)nw; asm volatile("" : "+s"(mvi_), "+s"(nwi_)); const float* mv = (const float*)(const GAS float*)mvi_; const float* nwl = (const float*)(const GAS float*)nwi_; const float* shp = mv + ((which) ? 3 : 0) * DM; const float* scp = mv + ((which) ? 4 : 1) * DM; \
                float ss = 0.f; \
                _Pragma("unroll") for (int j = 0; j < 8; ++j) ss += (v[j].x * v[j].x + v[j].y * v[j].y) + (v[j].z * v[j].z + v[j].w * v[j].w); \
                const float rstd = rsqrtf(wave_sum(ss) * (1.f / DM) + EPS); \
                _Pragma("unroll") for (int j = 0; j < 4; ++j) { const int col = 8 * plane + 512 * j; u32x4 pk; \
                    { const f32x4 w4 = *(const f32x4*)(nwl + col), s4 = *(const f32x4*)(scp + col), h4 = *(const f32x4*)(shp + col); const f32x4 y = v[2 * j] * rstd * w4 * (s4 + 1.f) + h4; pk.x = cvt_pk_bf16(y.x, y.y); pk.y = cvt_pk_bf16(y.z, y.w); } \
                    { const f32x4 w4 = *(const f32x4*)(nwl + col + 4), s4 = *(const f32x4*)(scp + col + 4), h4 = *(const f32x4*)(shp + col + 4); const f32x4 y = v[2 * j + 1] * rstd * w4 * (s4 + 1.f) + h4; pk.z = cvt_pk_bf16(y.x, y.y); pk.w = cvt_pk_bf16(y.z, y.w); } \
                    *(u32x4*)(Hb + (size_t)n * DM + col) = pk; } \
                n += pNGW; \
              } } while (0)
#define NORM_PHASE(which) do { PH_BEGIN \
            const float* nw = ldin((which) ? I_N2W : I_N1W) + (size_t)L * DM; \
            const float* xin = (!(which) && L == 0) ? ldin(I_X) : nullptr;              \
              \
            if (!((which) && L == 3)) { \
                const int nparts = (which) ? 8 : (L > 0 ? 11 : 0); \
                volatile LAS float* red = (volatile LAS float*)F.lds; \
                for (int r = pvcu; r < NCTX; r += pG) { \
                    const int col = 4 * ptid; \
                    const h16x4 hx = *(const h16x4*)(XW + (size_t)r * DM + col); \
                    f32x4 a = __builtin_convertvector(hx, f32x4); \
                    if (nparts > 0) { f32x4 s[11]; const float* sp = SLAB + (size_t)r * DM + col; \
                        _Pragma("unroll") for (int pp = 0; pp < 8; ++pp) s[pp] = *(const f32x4*)(sp + (size_t)pp * NCTX * DM); \
                        _Pragma("unroll") for (int pp = 8; pp < 11; ++pp) s[pp] = *(const f32x4*)(sp + (size_t)(nparts > 8 ? pp : 0) * NCTX * DM); \
                        _Pragma("unroll") for (int pp = 0; pp < 8; ++pp) a = a + s[pp]; \
                        if (nparts > 8) a = a + ((s[8] + s[9]) + s[10]); \
                        *(h16x4*)(XW + (size_t)r * DM + col) = __builtin_convertvector(a, h16x4); } \
                    const float ps = wave_sum((a.x * a.x + a.y * a.y) + (a.z * a.z + a.w * a.w)); \
                    if (plane == 0) red[pwave] = ps; \
                    const float* mv = modL + 12288; const float* shp = mv + ((which) ? 3 : 0) * DM; const float* scp = mv + ((which) ? 4 : 1) * DM; \
                    const f32x4 w4 = *(const f32x4*)(nw + col), s4 = *(const f32x4*)(scp + col), h4 = *(const f32x4*)(shp + col); \
                    __syncthreads(); \
                    const float tot = ((red[0] + red[1]) + (red[2] + red[3])) + ((red[4] + red[5]) + (red[6] + red[7])); \
                    const float rstd = rsqrtf(tot * (1.f / DM) + EPS); \
                    const f32x4 y = a * rstd * w4 * (s4 + 1.f) + h4; \
                    u32x2 pk; pk.x = cvt_pk_bf16(y.x, y.y); pk.y = cvt_pk_bf16(y.z, y.w); \
                    *(u32x2*)(Hb + (size_t)r * DM + col) = pk; \
                    __syncthreads(); \
                } } \
              \
            if (xin != nullptr) NORM_LATENT(which, 1); else NORM_LATENT(which, 0); } while (0)

        if (IN(pb + 0)) { NORM_PHASE(0); }
        SEAM(pb + 0);

        if (IN(pb + 1)) { PH_BEGIN
            if (!odd) {
                pg8::Gemm g{Hb, (const bf16_t*)(ws + WS_WIN + (size_t)L * 26 * MiB), NT, NIN_E, DM, DM, DM};
                pg8::StaticOrder S; S.init(NT / 256, NIN_E / 256, pG, (int)blockIdx.x, 0);
                pg8::EpiEvenIn E{PROJ, ROPE, ctl + CW_KM + jl * 32};
                pg8::gemm_phase<pg8::EpiEvenIn, pg8::StaticOrder, true, true>(F.lds, g, S, E, pwave);
                TAIL_CONV(S.nwg, 2 * L);

            } else {
                pg8::Gemm g{Hb, (const bf16_t*)(ws + WS_WIN + (size_t)L * 26 * MiB), NT, NIN_O, DM, DM, DM};
                pg8::StaticOrder S; S.init(NT / 256, NIN_O / 256, pG, (int)blockIdx.x, 0);
                pg8::EpiOddIn2 E{PROJ, UCb, A2b};
                pg8::gemm_phase<pg8::EpiOddIn2, pg8::StaticOrder, true, true>(F.lds, g, S, E, pwave);
                TAIL_CONV(S.nwg, 2 * L);

            }
        }
        SEAM(pb + 1);

        {
        if (IN(pb + 2)) { PH_BEGIN
            if (!odd) {
                const float lam = LAMV[jl * 2], omli = LAMV[jl * 2 + 1];
                const float* subln = ldin(I_SUBLN) + jl * 128;
                for (int ui = pvcu; ui < 520; ui += pG) {
                    int h, row0, seq;
                    if (ui < 512) { h = ui >> 6; row0 = NCTX + (ui & 63) * 256; seq = NT; } else { h = ui - 512; row0 = 0; seq = NCTX; }
                    const float* kmp = (const float*)(ctl + CW_KM) + (jl * 8 + h) * 4;
                    da::diff_unit(PROJ, h, row0, seq, kmp[0] + kmp[1], kmp[2] + kmp[3], lam, omli, subln, O1, MIX, F.ldsg, pwave);
                }
                __syncthreads();
                for (int ui = pvcu; ui < 520; ui += pG) {
                    int h, qb; if (ui < 512) { h = ui >> 6; qb = ui & 63; } else { h = ui - 512; qb = -1; }
                    rt::na_unit(PROJ, h, qb, ldin(I_RPB) + (size_t)(jl * 8 + h) * 15 * 31, MIX, F.ldsg, pwave);
                }
            } else {
                {
                    pg8::Gemm g{UCb, W1Tb + (size_t)jl * 32 * 256 * 256, 32 * 1280, 256, 256, 256, 256};
                    pg8::BatchOrder S{160, pG, (int)blockIdx.x};
                    pg8::EpiS5E E{Eb};
                    pg8::gemm_phase<pg8::EpiS5E, pg8::BatchOrder, true, true>(F.lds, g, S, E, pwave);
                }
                for (int ui = (pvcu + pG - (20 % pG)) % pG; ui < 12 * rt::NCH; ui += pG) {
                    const int h = ui / rt::NCH, k = ui % rt::NCH;
                    const float lgf = -log1pf(expf(-ldin(I_DECAY)[(jl * 2 + 0) * 12 + h])) * LOG2E, lgr = -log1pf(expf(-ldin(I_DECAY)[(jl * 2 + 1) * 12 + h])) * LOG2E;
                    rt::kv_unit(PROJ, h, k, lgf, lgr, KVb, F.ldsg, pwave);
                }
            }
        }
        SEAM(pb + 2);

        if (odd && IN(pb + 3)) { PH_BEGIN
            for (int it = pvcu; it < 64; it += pG) {
                const int dir = it >> 5, g = it & 31, p = plane;
                const int pg = (jl * 2 + dir) * 32 + g;
                const float lr = ldin(I_LAMRE)[pg * 64 + p], li = ldin(I_LAMIM)[pg * 64 + p];
                const float dt = expf(ldin(I_LOGSTEP)[pg]);
                const float mag = expf(16.f * lr * dt); float sn, cs; sincosf(16.f * li * dt, &sn, &cs);
                const float ar = mag * cs, ai = mag * sn;
                const float* Eg = Eb + (size_t)(g * 1280) * 256 + dir * 128 + 2 * p; bf16_t* Hg = A2b + (size_t)(g * 1280) * 512 + 256 + dir * 128 + 2 * p;
                LAS f32x2* segT = (LAS f32x2*)F.lds;
                float hr = 0.f, hi2 = 0.f, pwr = 1.f, pwi = 0.f;
                const int s0 = 130 * pwave;
#define S5ROW(s_) (dir == 0 ? ((s_) < 16 ? (s_) : 240 + (s_)) : ((s_) < 16 ? 15 - (s_) : 1295 - (s_)))
                for (int b = 0; b < 5; ++b) {
                    f32x2 e[26];
#pragma unroll
                    for (int q = 0; q < 26; ++q) { const int s_ = s0 + b * 26 + q; e[q] = *(const f32x2*)(Eg + (size_t)S5ROW(s_) * 256); }
#pragma unroll
                    for (int q = 0; q < 26; ++q) { const float nhr = ar * hr - ai * hi2 + e[q].x, nhi = ar * hi2 + ai * hr + e[q].y; hr = nhr; hi2 = nhi;
                        const float t2 = pwr * ar - pwi * ai; pwi = pwr * ai + pwi * ar; pwr = t2; }
                }
                segT[pwave * 64 + p] = (f32x2){hr, hi2};
                __syncthreads();
                hr = 0.f; hi2 = 0.f;
                for (int v = 0; v < pwave; ++v) { const f32x2 T = segT[v * 64 + p]; const float nhr = pwr * hr - pwi * hi2 + T.x, nhi = pwr * hi2 + pwi * hr + T.y; hr = nhr; hi2 = nhi; }
                for (int b = 0; b < 5; ++b) {
                    f32x2 e[26];
#pragma unroll
                    for (int q = 0; q < 26; ++q) { const int s_ = s0 + b * 26 + q; e[q] = *(const f32x2*)(Eg + (size_t)S5ROW(s_) * 256); }
#pragma unroll
                    for (int q = 0; q < 26; ++q) { const int s_ = s0 + b * 26 + q; *(unsigned*)(Hg + (size_t)S5ROW(s_) * 512) = cvt_pk_bf16(hr, hi2);
                        const float nhr = ar * hr - ai * hi2 + e[q].x, nhi = ar * hi2 + ai * hr + e[q].y; hr = nhr; hi2 = nhi; }
                }
#undef S5ROW
                __syncthreads();
            }
            for (int idx = pvcu * 512 + ptid; idx < 2 * 12 * 4096; idx += pG * 512) {
                const int dir = idx / (12 * 4096), h = (idx >> 12) % 12, e = idx & 4095;
                const float lg2 = -log1pf(expf(-ldin(I_DECAY)[(jl * 2 + dir) * 12 + h])) * LOG2E;
                const float gC = __builtin_amdgcn_exp2f(lg2 * 256.f);
                const size_t base = (size_t)(dir * 12 + h) * rt::NCH * 16384 + (size_t)e * 4;
                const h16* kvp = KVb + base; bf16_t* sp = SINb + base;
                f32x4 S = {0.f, 0.f, 0.f, 0.f};
                const long stp = dir ? -16384 : 16384; const long o1 = dir ? 64 * 16384 : 16384;
#define R2OFF(i_) ((i_) == 0 ? 0L : o1 + (long)((i_) - 1) * stp)
                typedef _Float16 h16x4 __attribute__((ext_vector_type(4)));
                h16x4 kv[13];
#pragma unroll
                for (int q = 0; q < 13; ++q) kv[q] = *(const h16x4*)(kvp + R2OFF(q));
#pragma unroll
                for (int b = 0; b < 5; ++b) {
                    h16x4 nx[13];
                    if (b < 4) {
#pragma unroll
                        for (int q = 0; q < 13; ++q) nx[q] = *(const h16x4*)(kvp + R2OFF((b + 1) * 13 + q));
                    }
#pragma unroll
                    for (int q = 0; q < 13; ++q) { u32x2 pk; pk.x = cvt_pk_bf16(S.x, S.y); pk.y = cvt_pk_bf16(S.z, S.w); *(u32x2*)(sp + R2OFF(b * 13 + q)) = pk; S = S * gC + __builtin_convertvector(kv[q], f32x4); }
                    if (b < 4) {
#pragma unroll
                        for (int q = 0; q < 13; ++q) kv[q] = nx[q];
                    }
                }
#undef R2OFF
            }
        }
        if (odd) SEAM(pb + 3);

        if (odd && IN(pb + 4)) { PH_BEGIN
            {
                pg8::Gemm g{A2b, W2Tb + (size_t)jl * 32 * 256 * 512, 32 * 1280, 256, 512, 512, 512};
                pg8::BatchOrder S{160, pG, (int)blockIdx.x};
                pg8::EpiS5Y E{YGb};
                pg8::gemm_phase<pg8::EpiS5Y, pg8::BatchOrder, true, true>(F.lds, g, S, E, pwave);
            }
            for (int ui = (pvcu + pG - (20 % pG)) % pG; ui < 12 * rt::NCH; ui += pG) {
                const int h = ui / rt::NCH, k = ui % rt::NCH;
                const float lgf = -log1pf(expf(-ldin(I_DECAY)[(jl * 2 + 0) * 12 + h])) * LOG2E, lgr = -log1pf(expf(-ldin(I_DECAY)[(jl * 2 + 1) * 12 + h])) * LOG2E;
                rt::out_unit(PROJ, h, k, lgf, lgr, SINb, MIX, F.ldsg, pwave);
            }
            __syncthreads();
        }
        if (odd) SEAM(pb + 4);
        if (odd && IN(pb + 5)) { PH_BEGIN
            pg8::Gemm g{YGb, WGTb + (size_t)jl * 512 * 512, NT, 512, 512, 512, 512};
            pg8::StaticOrder S; S.init(NT / 256, 2, pG, (int)blockIdx.x, 0);
            pg8::EpiGlu E{YGb, MIX};
            pg8::gemm_phase<pg8::EpiGlu, pg8::StaticOrder, true, true>(F.lds, g, S, E, pwave);
        }
        if (odd) SEAM(pb + 5);
        }

        if (IN(pb + 6)) { PH_BEGIN
            pg8::Gemm g{MIX, (const bf16_t*)(ws + WS_WOUT + (size_t)L * 8 * MiB), NT, DM, DM, DM, DM};
            pg8::SplitOrder S; S.so.init(64, DM / 256, pG, (int)blockIdx.x, 1); S.nmini = L == 3 ? 0 : 64; S.ntp = 4;
            pg8::EpiResid E{XW, L == 0 ? ldin(I_X) : nullptr, modL + 2 * DM, modL + 12288 + 2 * DM, SLAB};
            pg8::gemm_phase<pg8::EpiResid, pg8::SplitOrder, true, true>(F.lds, g, S, E, pwave);

        }
        SEAM(pb + 6);

        if (IN(pb + 7)) { NORM_PHASE(1); }
        SEAM(pb + 7);

        if (IN(pb + 8)) { PH_BEGIN
            pg8::Gemm g{Hb, (const bf16_t*)(ws + WS_W13 + (size_t)L * 44 * MiB), NT, 2 * DFF, DM, DM, DM};
            pg8::StaticOrder S; S.init(L == 3 ? 64 : 65, 2 * DFF / 256, pG, (int)blockIdx.x, L == 3 ? 1 : 0);
            pg8::EpiSwiglu E{ACT};
            pg8::gemm_phase<pg8::EpiSwiglu, pg8::StaticOrder, true, true>(F.lds, g, S, E, pwave);
            TAIL_CONV(S.nwg, 2 * L + 1);

        }
        SEAM(pb + 8);

        if (IN(pb + 9)) { PH_BEGIN
            pg8::Gemm g{ACT, (const bf16_t*)(ws + WS_W2 + (size_t)L * 22 * MiB), NT, DM, DFF, DFF, DFF};
            pg8::SplitOrder S; S.so.init(64, DM / 256, pG, (int)blockIdx.x, 1); S.nmini = L == 3 ? 0 : 88; S.ntp = 8;
            pg8::EpiResid E{XW, nullptr, modL + 5 * DM, modL + 12288 + 5 * DM, SLAB};
            pg8::gemm_phase<pg8::EpiResid, pg8::SplitOrder, true, true>(F.lds, g, S, E, pwave);

        }
        SEAM(pb + 9);
    }

    if (IN(P_FINAL)) { PH_BEGIN
        const float* fw = ldin(I_FNW);
        { const float* xin = nullptr; (void)xin;
          int n = NCTX + pgw;
          u32x4 r1[4], r2[4];
          NORM_LOAD(0, n, r1); NORM_LOAD(0, n + pNGW, r2);
          while (n < NT) {
            f32x4 v[8]; float ss = 0.f;
            NORM_CVT(0, r1, v);
#pragma unroll
            for (int j = 0; j < 4; ++j) r1[j] = r2[j];
            NORM_LOAD(0, n + 2 * pNGW, r2);
#pragma unroll
            for (int j = 0; j < 8; ++j) ss += (v[j].x * v[j].x + v[j].y * v[j].y) + (v[j].z * v[j].z + v[j].w * v[j].w);
            const float rstd = rsqrtf(wave_sum(ss) * (1.f / DM) + EPS);
            float* orow = (float*)ldin(31) + (size_t)(n - NCTX) * DM + 8 * plane;
#pragma unroll
            for (int j = 0; j < 4; ++j) { const int col = 8 * plane + 512 * j;
                *(f32x4*)(orow + 512 * j) = v[2 * j] * rstd * *(const f32x4*)(fw + col); *(f32x4*)(orow + 512 * j + 4) = v[2 * j + 1] * rstd * *(const f32x4*)(fw + col + 4); }
            n += pNGW;
          } }
    }
#undef IN
#undef SEAM
#undef NORM_PHASE
#undef NORM_LOAD
#undef TAIL_CONV
#undef NORM_CVT
#undef NORM_LATENT
#undef MOD
#undef ROPE
#undef LAMV
#undef XW
#undef Hb
#undef PROJ
#undef ACT
#undef MIX
#undef Ub
#undef Y2
#undef ORb
#undef O1
#undef KVb
#undef SINb
#undef modL
#undef SLAB
#undef UCb
#undef A2b
#undef Eb
#undef YGb
#undef W1Tb
#undef W2Tb
#undef WGTb
#undef PH_BEGIN
}

#ifndef N_LAUNCH_MODE
#define N_LAUNCH_MODE 1
#endif
extern "C" void kernel_launch(void* const* d_in, const int* in_sizes, int n_in, void* d_out, int out_size, void* d_ws, size_t ws_size, hipStream_t stream) {
    static int grid = 0;
    if (grid == 0) {
        if (n_in != 31 || out_size != SEQ * DM || ws_size < WS_END) { fprintf(stderr, "kernel_launch: shape mismatch n_in %d out %d ws %zu (need %zu)\n", n_in, out_size, ws_size, (size_t)WS_END); grid = -1; return; }
        int dev = 0, cus = 0, per_cu = 0;
        if (hipGetDevice(&dev) != hipSuccess || hipDeviceGetAttribute(&cus, hipDeviceAttributeMultiprocessorCount, dev) != hipSuccess) { grid = -1; return; }
        if (hipFuncSetAttribute((const void*)fwd, hipFuncAttributeMaxDynamicSharedMemorySize, LDS_BYTES) != hipSuccess) { fprintf(stderr, "kernel_launch: hipFuncSetAttribute failed\n"); grid = -1; return; }
        if (hipOccupancyMaxActiveBlocksPerMultiprocessor(&per_cu, (const void*)fwd, 512, LDS_BYTES) != hipSuccess || per_cu < 1)
            fprintf(stderr, "kernel_launch: occupancy query reports %d blocks per CU\n", per_cu);
        (void)hipGetLastError();
        grid = cus;
    }
    if (grid < 0) return;
    if (hipMemsetAsync((char*)d_ws + WS_CTL, 0, CTL_ZERO_BYTES, stream) != hipSuccess) return;
    Args a{};
    for (int i = 0; i < 31; ++i) a.in[i] = (const float*)d_in[i];
    a.out = (float*)d_out; a.ws = (unsigned char*)d_ws; a.pad = 0;
    if (N_LAUNCH_MODE == 1) {
        a.ph_lo = 0; a.ph_hi = NPHASE; a.li = 0;
        hipLaunchKernelGGL(fwd, dim3(grid), dim3(512), LDS_BYTES, stream, a);
    } else {
        for (int p = 0; p < NPHASE; ++p) {
            const int k = p == 0 ? -1 : (p - 1) % PH_PER_LAYER; const int L = p == 0 ? -1 : (p - 1) / PH_PER_LAYER;
            if (p != 0 && p != P_FINAL && k >= 3 && k <= 5 && (L & 1) == 0) continue;
            a.ph_lo = p; a.ph_hi = p + 1; a.li = 0;
            hipLaunchKernelGGL(fwd, dim3(grid), dim3(512), LDS_BYTES, stream, a);
        }
    }
    const hipError_t le = hipPeekAtLastError();
    if (le != hipSuccess) fprintf(stderr, "kernel_launch: launch failed: %s\n", hipGetErrorName(le));
}
```

```cpp
#include <hip/hip_runtime.h>
#include <cstdio>
#include <cstdint>

#define LAS __attribute__((address_space(3)))
#define GAS __attribute__((address_space(1)))
typedef unsigned short bf16_t;
typedef short bf16x8 __attribute__((ext_vector_type(8)));
typedef short s16x4 __attribute__((ext_vector_type(4)));
typedef float f32x2 __attribute__((ext_vector_type(2)));
typedef float f32x4 __attribute__((ext_vector_type(4)));
typedef float f32x16 __attribute__((ext_vector_type(16)));
typedef unsigned u32x2 __attribute__((ext_vector_type(2)));
typedef unsigned u32x4 __attribute__((ext_vector_type(4)));

typedef _Float16 h16;
typedef _Float16 h16x8 __attribute__((ext_vector_type(8)));
typedef _Float16 h16x4 __attribute__((ext_vector_type(4)));
typedef float f32x8 __attribute__((ext_vector_type(8)));
__device__ __forceinline__ void ld8h(const h16* p, f32x4& a, f32x4& b) { const h16x8 h = *(const h16x8*)p; const f32x8 f = __builtin_convertvector(h, f32x8); a = (f32x4){f[0], f[1], f[2], f[3]}; b = (f32x4){f[4], f[5], f[6], f[7]}; }
__device__ __forceinline__ void st8h(h16* p, const f32x4 a, const f32x4 b) { const f32x8 f = {a.x, a.y, a.z, a.w, b.x, b.y, b.z, b.w}; *(h16x8*)p = __builtin_convertvector(f, h16x8); }
constexpr int DM = 2048, SEQ = 16384, NCTX = 256, NT = SEQ + NCTX;
constexpr int DFF = 5632, LDP = 6144;
constexpr int NIN_E = 6144, NIN_O = 6656;
constexpr float LOG2E = 1.4426950408889634f;
constexpr float EPS = 1e-6f;

constexpr size_t MiB = 1u << 20;
constexpr size_t WS_CTL = 0, CTL_ZERO_BYTES = 1 * MiB;
constexpr size_t WS_MOD = 1 * MiB;
constexpr size_t WS_ROPE = WS_MOD + 512 * 1024;
constexpr size_t WS_LAM = WS_ROPE + 64 * 1024;
constexpr size_t WS_WIN = 2 * MiB;
constexpr size_t WS_WOUT = WS_WIN + 4 * 26 * MiB;
constexpr size_t WS_W13 = WS_WOUT + 4 * 8 * MiB;
constexpr size_t WS_W2 = WS_W13 + 4 * 44 * MiB;
constexpr size_t WS_XW = WS_W2 + 4 * 22 * MiB;
constexpr size_t WS_H = WS_XW + 130 * MiB;
constexpr size_t WS_PROJ = WS_H + 65 * MiB;
constexpr size_t WS_MIX = WS_PROJ + 195 * MiB;
constexpr size_t WS_U = WS_MIX + 65 * MiB;
constexpr size_t WS_Y2 = WS_U + 33 * MiB;
constexpr size_t WS_OR = WS_Y2 + 65 * MiB;
constexpr size_t WS_O1 = WS_OR + 195 * MiB;
constexpr size_t WS_UC = WS_O1 + 65 * MiB;
constexpr size_t WS_A2 = WS_UC + 20 * MiB;
constexpr size_t WS_E = WS_A2 + 40 * MiB;
constexpr size_t WS_YG = WS_E + 40 * MiB;
constexpr size_t WS_W1T = WS_YG + 17 * MiB;
constexpr size_t WS_W2T = WS_W1T + 8 * MiB;
constexpr size_t WS_WGT = WS_W2T + 16 * MiB;
constexpr size_t WS_END = WS_WGT + 1 * MiB;
static_assert((size_t)NT * DM * 4 <= 130 * MiB && (size_t)NT * LDP * 2 <= 195 * MiB && (size_t)NT * 1536 * 4 * 2 <= 195 * MiB, "ws map");

constexpr int CW_BAR = 4096, BAR_STRIDE = 4096, CW_KM = 131072, CW_DQ = CW_KM + 1024;

constexpr int RING_BYTES = 131072;
constexpr int LDSCTL_OFF = RING_BYTES, MISC_OFF = LDSCTL_OFF + 320;
constexpr int LDS_BYTES = 147456;

__device__ __forceinline__ float bf2f(unsigned short b) { return __uint_as_float((unsigned)b << 16); }
__device__ __forceinline__ unsigned cvt_pk_bf16(float lo, float hi) { unsigned r; asm volatile("v_cvt_pk_bf16_f32 %0, %1, %2" : "=v"(r) : "v"(lo), "v"(hi)); return r; }
template <int M> __device__ __forceinline__ float swz_xor(float v) { return __int_as_float(__builtin_amdgcn_ds_swizzle(__float_as_int(v), (M << 10) | 0x1f)); }
__device__ __forceinline__ float half_sum32(float v) { v += swz_xor<1>(v); v += swz_xor<2>(v); v += swz_xor<4>(v); v += swz_xor<8>(v); v += swz_xor<16>(v); return v; }
__device__ __forceinline__ float wave_sum(float v) {
    v = half_sum32(v);
    auto rr = __builtin_amdgcn_permlane32_swap(__float_as_uint(v), __float_as_uint(v), false, false);
    return __uint_as_float(rr[0]) + __uint_as_float(rr[1]);
}
__device__ __forceinline__ float wave_max(float v) {
    v = fmaxf(v, swz_xor<1>(v)); v = fmaxf(v, swz_xor<2>(v)); v = fmaxf(v, swz_xor<4>(v)); v = fmaxf(v, swz_xor<8>(v)); v = fmaxf(v, swz_xor<16>(v));
    auto rr = __builtin_amdgcn_permlane32_swap(__float_as_uint(v), __float_as_uint(v), false, false);
    return fmaxf(__uint_as_float(rr[0]), __uint_as_float(rr[1]));
}
__device__ __forceinline__ float xor32(float v, int hi) { auto rr = __builtin_amdgcn_permlane32_swap(__float_as_uint(v), __float_as_uint(v), false, false); return __uint_as_float(hi ? rr[0] : rr[1]); }
__device__ __forceinline__ float silu_f(float x) { return x / (1.f + __expf(-x)); }
__device__ __forceinline__ int lane_now() { int l; asm volatile("v_mbcnt_lo_u32_b32 %0, -1, 0\n\tv_mbcnt_hi_u32_b32 %0, -1, %0" : "=v"(l)); return l; }
#define LDS_WAIT() asm volatile("s_waitcnt lgkmcnt(0)" ::: "memory")
#define VM_WAIT() asm volatile("s_waitcnt vmcnt(0)" ::: "memory")

namespace pg8 {
constexpr int BM = 256, BK = 64, HALF = 128, HTB = HALF * BK * 2, STAGE_BYTES = 8 * HTB, NXCD = 8, WGM = 8;
__host__ __device__ __forceinline__ int lds_byte(int r, int c) { const int st = (r >> 4) * 2 + (c >> 5), rr = r & 15, cc = c & 31, ob = rr * 64 + cc * 2; return st * 1024 + (ob ^ (((ob >> 9) & 1) << 5)); }
__host__ __device__ __forceinline__ void stage_rc(int b, int& R, int& C) { const int st = b / 1024, sb = b % 1024, swz = sb ^ (((sb >> 9) & 1) << 5); R = (st >> 1) * 16 + swz / 64; C = (st & 1) * 32 + (swz % 64) / 2; }
__host__ __device__ __forceinline__ int perm32(int rho) { const int n = rho >> 4, i = rho & 15; return 8 * (i >> 2) + 4 * n + (i & 3); }

struct Unit { int pm, pn, kt0, ntu; };
struct Gemm { const bf16_t* A; const bf16_t* Bt; int M, N, K, lda, ldb; };

struct StaticOrder {
    int nM, nN, nwg, G, c, pm0;
    __host__ __device__ void init(int nM_, int nN_, int G_, int c_, int pm0_) { nM = nM_; nN = nN_; nwg = nM * nN; G = G_; c = c_; pm0 = pm0_; }
    __host__ __device__ bool next(int i, Unit& u) const {
        const long L = (long)i * G + c; if (L >= nwg) return false;
        int wgid = (int)L; { const int q = nwg / NXCD, r = nwg % NXCD, xcd = wgid % NXCD, off = wgid / NXCD; wgid = (xcd < r ? xcd * (q + 1) : r * (q + 1) + (xcd - r) * q) + off; }
        const int nig = WGM * nN, gid = wgid / nig, fm = gid * WGM, gsz = (nM - fm) < WGM ? (nM - fm) : WGM;
        u.pm = pm0 + fm + ((wgid % nig) % gsz); u.pn = (wgid % nig) / gsz; u.kt0 = 0; u.ntu = 0; return true;
    }
    __device__ __forceinline__ void a_ready(const Unit&) const {}
    __device__ __forceinline__ void done(const Unit&) const {}
};

struct SplitOrder {
    StaticOrder so; int nmini, ntp;
    __host__ __device__ bool next(int i, Unit& u) const {
        if (so.next(i, u)) return true;
        const long L = (long)i * so.G + so.c - (long)(((so.nwg + so.G - 1) / so.G) * so.G);
        if (L < 0 || L >= nmini) return false;
        u.pm = 0; u.pn = (int)L & 7; u.kt0 = ((int)L >> 3) * ntp; u.ntu = ntp; return true;
    }
    __device__ __forceinline__ void a_ready(const Unit&) const {}
    __device__ __forceinline__ void done(const Unit&) const {}
};
template <class Epi, class Sched, bool ALIGN_EPI = false, bool SP2 = false>
__device__ __forceinline__ void gemm_phase(LAS unsigned char* lds, const Gemm g, const Sched& S, const Epi& E, const int wv) {
    const int wid = wv, lane = lane_now(), tid = wid * 64 + lane;
    const int wr = wid >> 2, wc = wid & 3, fr = lane & 15, fq = lane >> 4;
    const int K = g.K, nt = K / BK;
    unsigned voffA[2], voffB[2];
#pragma unroll
    for (int i = 0; i < 2; ++i) { int R, C; stage_rc(tid * 16 + i * 8192, R, C); const int Rb = Epi::PERM ? ((R & ~31) + perm32(R & 31)) : R;
        voffA[i] = (unsigned)(R * K + C) * 2u; voffB[i] = (unsigned)(Rb * K + C) * 2u; }
    const size_t kstep = (size_t)(BK * 2);
    const size_t hA = (size_t)HALF * K * 2;
#define hB hA
#define tA (2 * hA)
#define tB (2 * hA)
    const unsigned ldsw = (unsigned)wid * 1024u;
    const int aoff = lds_byte(wr * 64 + fr, fq * 8), boff = lds_byte(wc * 32 + fr, fq * 8);
#define PG8_SA(b, h) (((b) * 2 + (h)) * HTB)
#define PG8_SB(b, h) ((4 + (b) * 2 + (h)) * HTB)
#define PG8_STAGE(bufoff, gbase, voff) do { _Pragma("unroll") for (int _i = 0; _i < 2; ++_i) \
        __builtin_amdgcn_global_load_lds((const unsigned*)((const char*)(gbase) + (voff)[_i]), (LAS unsigned*)(lds + (bufoff) + ldsw + _i * 8192), 16, 0, 0); } while (0)
#define PG8_LDA(dst, b, h) do { _Pragma("unroll") for (int m = 0; m < 4; ++m) _Pragma("unroll") for (int k = 0; k < 2; ++k) dst[m][k] = *(const LAS bf16x8*)(lds + PG8_SA(b, h) + aoff + m * 2048 + k * 1024); } while (0)
#define PG8_LDB(dst, b, h) do { _Pragma("unroll") for (int n = 0; n < 2; ++n) _Pragma("unroll") for (int k = 0; k < 2; ++k) dst[n][k] = *(const LAS bf16x8*)(lds + PG8_SB(b, h) + boff + n * 2048 + k * 1024); } while (0)
#define PG8_MMA(ai, bj, At, Bt) do { __builtin_amdgcn_s_setprio(1); _Pragma("unroll") for (int m = 0; m < 4; ++m) _Pragma("unroll") for (int n = 0; n < 2; ++n) _Pragma("unroll") for (int k = 0; k < 2; ++k) \
        acc[ai][bj][m][n] = __builtin_amdgcn_mfma_f32_16x16x32_bf16(Bt[n][k], At[m][k], acc[ai][bj][m][n], 0, 0, 0); __builtin_amdgcn_s_setprio(0); } while (0)
#define PG8_WAIT_V(n) asm volatile("s_waitcnt vmcnt(" #n ")" ::: "memory")
#define PG8_WAIT_L(n) asm volatile("s_waitcnt lgkmcnt(" #n ")" ::: "memory")
#define PG8_BAR __builtin_amdgcn_s_barrier()
#define PG8_SCHED __builtin_amdgcn_sched_barrier(0)
    Unit cur, nxt; int ui = 0;
    if (!S.next(0, cur)) return;
    f32x4 acc[2][2][4][2];
#pragma unroll
    for (int a = 0; a < 2; ++a)
#pragma unroll
        for (int b = 0; b < 2; ++b)
#pragma unroll
            for (int m = 0; m < 4; ++m)
#pragma unroll
                for (int n = 0; n < 2; ++n) acc[a][b][m][n] = (f32x4){0.f, 0.f, 0.f, 0.f};
    bf16x8 At[4][2], B0[2][2], B1[2][2];
    const char* cA = (const char*)g.A + (size_t)cur.pm * tA + (size_t)cur.kt0 * kstep; const char* cB = (const char*)g.Bt + (size_t)cur.pn * tB + (size_t)cur.kt0 * kstep;
    S.a_ready(cur);
    if constexpr (SP2) {
        PG8_STAGE(PG8_SB(0, 0), cB, voffB); PG8_STAGE(PG8_SB(0, 1), cB + hB, voffB); PG8_STAGE(PG8_SA(0, 0), cA, voffA); PG8_STAGE(PG8_SA(0, 1), cA + hA, voffA);
        if (wr == 1) PG8_BAR;
        PG8_WAIT_V(2); PG8_BAR;
        PG8_STAGE(PG8_SB(1, 0), cB + kstep, voffB); PG8_STAGE(PG8_SA(1, 0), cA + kstep, voffA); PG8_STAGE(PG8_SB(1, 1), cB + hB + kstep, voffB);
        PG8_WAIT_V(6); PG8_BAR;
    } else {
        PG8_STAGE(PG8_SB(0, 0), cB, voffB); PG8_STAGE(PG8_SA(0, 0), cA, voffA); PG8_STAGE(PG8_SB(0, 1), cB + hB, voffB); PG8_STAGE(PG8_SA(0, 1), cA + hA, voffA);
        if (wr == 1) PG8_BAR;
        PG8_WAIT_V(4); PG8_BAR;
        PG8_STAGE(PG8_SB(1, 0), cB + kstep, voffB); PG8_STAGE(PG8_SA(1, 0), cA + kstep, voffA); PG8_STAGE(PG8_SB(1, 1), cB + hB + kstep, voffB);
        PG8_WAIT_V(6); PG8_BAR;
    }
    for (;;) {
        const bool has_next = S.next(ui + 1, nxt);
        const char* nA = has_next ? (const char*)g.A + (size_t)nxt.pm * tA + (size_t)nxt.kt0 * kstep : cA; const char* nB = has_next ? (const char*)g.Bt + (size_t)nxt.pn * tB + (size_t)nxt.kt0 * kstep : cB;
        const int ntc = cur.ntu > 0 ? cur.ntu : nt;
        for (int t = 0; t < ntc; t += 2) {
            const bool last = (t == ntc - 2);
            const char* a1 = cA + (size_t)(t + 1) * kstep;
            const char* a2 = last ? nA : cA + (size_t)(t + 2) * kstep; const char* b2 = last ? nB : cB + (size_t)(t + 2) * kstep;
            const char* a3 = a2 + kstep; const char* b3 = b2 + kstep;
            if (last && has_next) S.a_ready(nxt);
            if constexpr (SP2) {
            PG8_LDB(B0, 0, 0); PG8_LDB(B1, 0, 1); PG8_SCHED; PG8_LDA(At, 0, 0); PG8_STAGE(PG8_SA(1, 1), a1 + hA, voffA);
            PG8_WAIT_V(8); PG8_WAIT_L(0); PG8_BAR; PG8_MMA(0, 0, At, B0); PG8_MMA(0, 1, At, B1); PG8_BAR; PG8_SCHED;
            PG8_LDA(At, 0, 1); PG8_STAGE(PG8_SB(0, 0), b2, voffB); PG8_STAGE(PG8_SB(0, 1), b2 + hB, voffB); PG8_STAGE(PG8_SA(0, 0), a2, voffA);
            PG8_WAIT_V(8); PG8_WAIT_L(0); PG8_BAR; PG8_MMA(1, 0, At, B0); PG8_MMA(1, 1, At, B1); PG8_BAR; PG8_SCHED;
            PG8_LDB(B0, 1, 0); PG8_LDB(B1, 1, 1); PG8_SCHED; PG8_LDA(At, 1, 0); PG8_STAGE(PG8_SA(0, 1), a2 + hA, voffA);
            PG8_WAIT_V(8); PG8_WAIT_L(0); PG8_BAR; PG8_MMA(0, 0, At, B0); PG8_MMA(0, 1, At, B1); PG8_BAR; PG8_SCHED;
            PG8_LDA(At, 1, 1); PG8_STAGE(PG8_SB(1, 0), b3, voffB); PG8_STAGE(PG8_SB(1, 1), b3 + hB, voffB); PG8_STAGE(PG8_SA(1, 0), a3, voffA);
            PG8_WAIT_V(8); PG8_WAIT_L(0); PG8_BAR; PG8_MMA(1, 0, At, B0); PG8_MMA(1, 1, At, B1); PG8_BAR; PG8_SCHED;
            } else {
            PG8_LDB(B0, 0, 0); PG8_SCHED; PG8_LDA(At, 0, 0); PG8_STAGE(PG8_SA(1, 1), a1 + hA, voffA);
            PG8_WAIT_L(8); PG8_BAR; PG8_WAIT_L(0); PG8_MMA(0, 0, At, B0); PG8_BAR; PG8_SCHED;
            PG8_LDB(B1, 0, 1); PG8_STAGE(PG8_SB(0, 0), b2, voffB);
            PG8_BAR; PG8_WAIT_L(0); PG8_MMA(0, 1, At, B1); PG8_BAR;
            PG8_LDA(At, 0, 1); PG8_STAGE(PG8_SA(0, 0), a2, voffA);
            PG8_BAR; PG8_WAIT_L(0); PG8_MMA(1, 0, At, B0); PG8_BAR; PG8_SCHED;
            PG8_STAGE(PG8_SB(0, 1), b2 + hB, voffB);
            PG8_WAIT_V(6); PG8_BAR; PG8_MMA(1, 1, At, B1); PG8_BAR;
            PG8_LDB(B0, 1, 0); PG8_SCHED; PG8_LDA(At, 1, 0); PG8_STAGE(PG8_SA(0, 1), a2 + hA, voffA);
            PG8_WAIT_L(8); PG8_BAR; PG8_WAIT_L(0); PG8_MMA(0, 0, At, B0); PG8_BAR; PG8_SCHED;
            PG8_LDB(B1, 1, 1); PG8_STAGE(PG8_SB(1, 0), b3, voffB);
            PG8_BAR; PG8_WAIT_L(0); PG8_MMA(0, 1, At, B1); PG8_BAR;
            PG8_LDA(At, 1, 1); PG8_STAGE(PG8_SA(1, 0), a3, voffA);
            PG8_BAR; PG8_WAIT_L(0); PG8_MMA(1, 0, At, B0); PG8_BAR; PG8_SCHED;
            PG8_STAGE(PG8_SB(1, 1), b3 + hB, voffB);
            PG8_WAIT_V(6); PG8_BAR; PG8_MMA(1, 1, At, B1); PG8_BAR;
            }
        }
        if constexpr (ALIGN_EPI) { if (wr == 0) PG8_BAR; }
        { const int t2 = lane_now(); E(acc, cur, wr, wc, t2 & 15, t2 >> 4); } S.done(cur);
        if (!has_next) break;
#pragma unroll
        for (int a = 0; a < 2; ++a)
#pragma unroll
            for (int b = 0; b < 2; ++b)
#pragma unroll
                for (int m = 0; m < 4; ++m)
#pragma unroll
                    for (int n = 0; n < 2; ++n) acc[a][b][m][n] = (f32x4){0.f, 0.f, 0.f, 0.f};
        cur = nxt; cA = nA; cB = nB; ++ui;
        if constexpr (ALIGN_EPI) { if (wr == 1) PG8_BAR; }
    }
    PG8_WAIT_V(0);
    if constexpr (!ALIGN_EPI) { if (wr == 0) PG8_BAR; }
    PG8_BAR;
#undef hB
#undef tA
#undef tB
#undef PG8_SA
#undef PG8_SB
#undef PG8_STAGE
#undef PG8_LDA
#undef PG8_LDB
#undef PG8_MMA
#undef PG8_WAIT_V
#undef PG8_WAIT_L
#undef PG8_BAR
#undef PG8_SCHED
}

struct EpiEvenIn {
    static constexpr bool PERM = true;
    bf16_t* P; const float* rope; unsigned* km;
    __device__ __forceinline__ void operator()(const f32x4 (&acc)[2][2][4][2], const Unit& u, int wr, int wc, int fr, int fq) const {
        const int region = u.pn >> 2;
        float kmax2[2] = {0.f, 0.f};
        const bool dorope = (region <= 1) && (u.pm != 0);
        const float sc = region == 0 ? 0.125f * LOG2E : (region == 3 ? 0.08838834764831845f * LOG2E : 1.f);
        const int colbase = u.pn * BM + wc * 32 + 8 * fq;
        const float sgn = (fq & 2) ? 1.f : -1.f;
#pragma unroll
        for (int ai = 0; ai < 2; ++ai)
#pragma unroll
            for (int m = 0; m < 4; ++m) {
                const int row = u.pm * BM + ai * HALF + wr * 64 + m * 16 + fr;
                f32x4 cs[4];
                if (dorope) { const int t = row - NCTX; const int pos = (wc & 1) ? (t & 63) : (t >> 6);
                    const f32x4* tb = (const f32x4*)(rope + (pos * 16 + 8 * (fq & 1)) * 2);
#pragma unroll
                    for (int q = 0; q < 4; ++q) cs[q] = tb[q]; }
#pragma unroll
                for (int bj = 0; bj < 2; ++bj) {
                    f32x4 v0 = acc[ai][bj][m][0], v1 = acc[ai][bj][m][1];
                    if (dorope) {
                        f32x4 p0, p1;
#pragma unroll
                        for (int e = 0; e < 4; ++e) { p0[e] = xor32(v0[e], fq >> 1); p1[e] = xor32(v1[e], fq >> 1); }
                        v0[0] = v0[0] * cs[0][0] + sgn * p0[0] * cs[0][1]; v0[1] = v0[1] * cs[0][2] + sgn * p0[1] * cs[0][3];
                        v0[2] = v0[2] * cs[1][0] + sgn * p0[2] * cs[1][1]; v0[3] = v0[3] * cs[1][2] + sgn * p0[3] * cs[1][3];
                        v1[0] = v1[0] * cs[2][0] + sgn * p1[0] * cs[2][1]; v1[1] = v1[1] * cs[2][2] + sgn * p1[1] * cs[2][3];
                        v1[2] = v1[2] * cs[3][0] + sgn * p1[2] * cs[3][1]; v1[3] = v1[3] * cs[3][2] + sgn * p1[3] * cs[3][3];
                    }
                    v0 = v0 * sc; v1 = v1 * sc;
                    if (region == 1) { float ss = (v0[0] * v0[0] + v0[1] * v0[1]) + (v0[2] * v0[2] + v0[3] * v0[3]) + (v1[0] * v1[0] + v1[1] * v1[1]) + (v1[2] * v1[2] + v1[3] * v1[3]);
                        ss += swz_xor<16>(ss); ss += xor32(ss, fq >> 1); kmax2[bj] = fmaxf(kmax2[bj], ss); }
                    u32x4 w; w.x = cvt_pk_bf16(v0[0], v0[1]); w.y = cvt_pk_bf16(v0[2], v0[3]); w.z = cvt_pk_bf16(v1[0], v1[1]); w.w = cvt_pk_bf16(v1[2], v1[3]);
                    *(u32x4*)(P + (size_t)row * LDP + colbase + bj * HALF) = w;
                }
            }
        if (region == 1) {
#pragma unroll
            for (int bj = 0; bj < 2; ++bj) { const float mx = wave_max(kmax2[bj]);
                if ((fr | fq) == 0) __hip_atomic_fetch_max(km + ((2 * (u.pn - 4) + bj) * 2 + (wc >> 1)) * 2 + (wc & 1), __float_as_uint(mx), __ATOMIC_RELAXED, __HIP_MEMORY_SCOPE_AGENT); }
        }
    }
};
struct EpiResid {
    static constexpr bool PERM = true;
    h16* X; const float* Xin; const float* gate_lat; const float* gate_ctx; float* slab;
    __device__ __forceinline__ void operator()(const f32x4 (&acc)[2][2][4][2], const Unit& u, int wr, int wc, int fr, int fq) const {
        const int colbase = u.pn * BM + wc * 32 + 8 * fq;
        const float* gp = (u.pm == 0 ? gate_ctx : gate_lat) + colbase;
        f32x4 g[2][2];
#pragma unroll
        for (int bj = 0; bj < 2; ++bj) { g[bj][0] = *(const f32x4*)(gp + bj * HALF); g[bj][1] = *(const f32x4*)(gp + bj * HALF + 4); }
        if (u.ntu > 0) {
#pragma unroll
            for (int ai = 0; ai < 2; ++ai)
#pragma unroll
                for (int m = 0; m < 4; ++m) { const int row = ai * HALF + wr * 64 + m * 16 + fr;
#pragma unroll
                    for (int bj = 0; bj < 2; ++bj) { float* sp = slab + ((size_t)(u.kt0 / u.ntu) * NCTX + row) * DM + colbase + bj * HALF;
                        *(f32x4*)sp = g[bj][0] * acc[ai][bj][m][0]; *(f32x4*)(sp + 4) = g[bj][1] * acc[ai][bj][m][1]; } }
            return;
        }
#pragma unroll
        for (int ai = 0; ai < 2; ++ai) {
            f32x4 xv[4][2][2];
#pragma unroll
            for (int m = 0; m < 4; ++m) { const size_t row = (size_t)(u.pm * BM + ai * HALF + wr * 64 + m * 16 + fr);
#pragma unroll
                for (int bj = 0; bj < 2; ++bj) {
                    if (Xin != nullptr) { const float* xp = Xin + (row - NCTX) * DM + colbase + bj * HALF; xv[m][bj][0] = *(const f32x4*)xp; xv[m][bj][1] = *(const f32x4*)(xp + 4); }
                    else ld8h(X + row * DM + colbase + bj * HALF, xv[m][bj][0], xv[m][bj][1]); } }
            asm volatile("" ::: "memory");
#pragma unroll
            for (int m = 0; m < 4; ++m) { h16* xp = X + (size_t)(u.pm * BM + ai * HALF + wr * 64 + m * 16 + fr) * DM + colbase;
#pragma unroll
                for (int bj = 0; bj < 2; ++bj) st8h(xp + bj * HALF, xv[m][bj][0] + g[bj][0] * acc[ai][bj][m][0], xv[m][bj][1] + g[bj][1] * acc[ai][bj][m][1]); }
        }
    }
};
struct EpiSwiglu {
    static constexpr bool PERM = true;
    bf16_t* ACT;
    __device__ __forceinline__ void operator()(const f32x4 (&acc)[2][2][4][2], const Unit& u, int wr, int wc, int fr, int fq) const {
        const int colbase = u.pn * HALF + wc * 32 + 8 * fq;
#pragma unroll
        for (int ai = 0; ai < 2; ++ai)
#pragma unroll
            for (int m = 0; m < 4; ++m) {
                const int row = u.pm * BM + ai * HALF + wr * 64 + m * 16 + fr;
                float r[8];
#pragma unroll
                for (int n = 0; n < 2; ++n)
#pragma unroll
                    for (int e = 0; e < 4; ++e) { const float a = acc[ai][0][m][n][e], b = acc[ai][1][m][n][e]; r[n * 4 + e] = a * __builtin_amdgcn_rcpf(1.f + __expf(-a)) * b; }
                u32x4 w; w.x = cvt_pk_bf16(r[0], r[1]); w.y = cvt_pk_bf16(r[2], r[3]); w.z = cvt_pk_bf16(r[4], r[5]); w.w = cvt_pk_bf16(r[6], r[7]);
                *(u32x4*)(ACT + (size_t)row * DFF + colbase) = w;
            }
    }
};

struct BatchOrder {
    int nunits, G, c;
    __host__ __device__ bool next(int i, Unit& u) const { const int L = i * G + c; if (L >= nunits) return false; u.pm = L; u.pn = L / 5; u.kt0 = 0; u.ntu = 0; return true; }
    __device__ __forceinline__ void a_ready(const Unit&) const {}
    __device__ __forceinline__ void done(const Unit&) const {}
};
struct EpiOddIn2 {
    static constexpr bool PERM = true;
    bf16_t* P; bf16_t* UC; bf16_t* A2;
    __device__ __forceinline__ void operator()(const f32x4 (&acc)[2][2][4][2], const Unit& u, int wr, int wc, int fr, int fq) const {
        const int colbase = u.pn * BM + wc * 32 + 8 * fq;
        const float sc = (u.pn >= 8 && u.pn < 14) ? 0.08838834764831845f : 1.f;
#pragma unroll
        for (int ai = 0; ai < 2; ++ai)
#pragma unroll
            for (int m = 0; m < 4; ++m) {
                const int row = u.pm * BM + ai * HALF + wr * 64 + m * 16 + fr;
                const int R = (row < NCTX) ? (row >> 4) : (row >> 4) + 240, t = row & 15;
#pragma unroll
                for (int bj = 0; bj < 2; ++bj) {
                    f32x4 v0 = acc[ai][bj][m][0] * sc, v1 = acc[ai][bj][m][1] * sc;
                    u32x4 w; w.x = cvt_pk_bf16(v0[0], v0[1]); w.y = cvt_pk_bf16(v0[2], v0[3]); w.z = cvt_pk_bf16(v1[0], v1[1]); w.w = cvt_pk_bf16(v1[2], v1[3]);
                    if (u.pn < 2) { const int ch = colbase + bj * HALF, g = ch >> 4, c0 = ch & 15;
                        *(u32x4*)(UC + ((size_t)(g * 1280 + R)) * 256 + t * 16 + c0) = w; *(u32x4*)(A2 + ((size_t)(g * 1280 + R)) * 512 + t * 16 + c0) = w; }
                    else *(u32x4*)(P + (size_t)row * LDP + (colbase - 512) + bj * HALF) = w;
                }
            }
    }
};
struct EpiS5E {
    static constexpr bool PERM = true;
    float* E;
    __device__ __forceinline__ void operator()(const f32x4 (&acc)[2][2][4][2], const Unit& u, int wr, int wc, int fr, int fq) const {
#pragma unroll
        for (int ai = 0; ai < 2; ++ai)
#pragma unroll
            for (int m = 0; m < 4; ++m) { float* ep = E + (size_t)(u.pm * BM + ai * HALF + wr * 64 + m * 16 + fr) * 256 + wc * 32 + 8 * fq;
#pragma unroll
                for (int bj = 0; bj < 2; ++bj) { *(f32x4*)(ep + bj * HALF) = acc[ai][bj][m][0]; *(f32x4*)(ep + bj * HALF + 4) = acc[ai][bj][m][1]; } }
    }
};
__device__ __forceinline__ float gelu_tanh_e(float x) { const float u = 0.7978845608028654f * (x + 0.044715f * x * x * x); const float e = __expf(2.f * u); return x * (1.f - __builtin_amdgcn_rcpf(e + 1.f)); }
struct EpiS5Y {
    static constexpr bool PERM = true;
    bf16_t* YG;
    __device__ __forceinline__ void operator()(const f32x4 (&acc)[2][2][4][2], const Unit& u, int wr, int wc, int fr, int fq) const {
        const int g = u.pn, panel = u.pm - 5 * g;
#pragma unroll
        for (int ai = 0; ai < 2; ++ai)
#pragma unroll
            for (int m = 0; m < 4; ++m) { const int Rl = panel * BM + ai * HALF + wr * 64 + m * 16 + fr;
                const bool ok = (panel != 0) || (Rl < 16); const int n0 = panel == 0 ? 16 * Rl : 16 * (Rl - 240);
#pragma unroll
                for (int bj = 0; bj < 2; ++bj) { const int t = 8 * bj + 2 * wc + (fq >> 1), c0 = 8 * (fq & 1);
                    const f32x4 v0 = acc[ai][bj][m][0], v1 = acc[ai][bj][m][1];
                    u32x4 w; w.x = cvt_pk_bf16(gelu_tanh_e(v0[0]), gelu_tanh_e(v0[1])); w.y = cvt_pk_bf16(gelu_tanh_e(v0[2]), gelu_tanh_e(v0[3]));
                    w.z = cvt_pk_bf16(gelu_tanh_e(v1[0]), gelu_tanh_e(v1[1])); w.w = cvt_pk_bf16(gelu_tanh_e(v1[2]), gelu_tanh_e(v1[3]));
                    if (ok) *(u32x4*)(YG + (size_t)(n0 + t) * 512 + g * 16 + c0) = w; } }
    }
};
struct EpiGlu {
    static constexpr bool PERM = true;
    const bf16_t* YG; bf16_t* MIXp;
    __device__ __forceinline__ void operator()(const f32x4 (&acc)[2][2][4][2], const Unit& u, int wr, int wc, int fr, int fq) const {
        const int colbase = u.pn * BM + wc * 32 + 8 * fq;
#pragma unroll
        for (int ai = 0; ai < 2; ++ai)
#pragma unroll
            for (int m = 0; m < 4; ++m) { const int row = u.pm * BM + ai * HALF + wr * 64 + m * 16 + fr;
#pragma unroll
                for (int bj = 0; bj < 2; ++bj) { const u32x4 y = *(const u32x4*)(YG + (size_t)row * 512 + colbase + bj * HALF);
                    const f32x4 v0 = acc[ai][bj][m][0], v1 = acc[ai][bj][m][1];
                    float r[8];
#pragma unroll
                    for (int e = 0; e < 4; ++e) { r[e] = __builtin_amdgcn_rcpf(1.f + __expf(-v0[e])); r[4 + e] = __builtin_amdgcn_rcpf(1.f + __expf(-v1[e])); }
                    u32x4 w;
                    w.x = cvt_pk_bf16(__uint_as_float(y.x << 16) * r[0], __uint_as_float(y.x & 0xffff0000u) * r[1]); w.y = cvt_pk_bf16(__uint_as_float(y.y << 16) * r[2], __uint_as_float(y.y & 0xffff0000u) * r[3]);
                    w.z = cvt_pk_bf16(__uint_as_float(y.z << 16) * r[4], __uint_as_float(y.z & 0xffff0000u) * r[5]); w.w = cvt_pk_bf16(__uint_as_float(y.w << 16) * r[6], __uint_as_float(y.w & 0xffff0000u) * r[7]);
                    *(u32x4*)(MIXp + (size_t)row * DM + colbase + bj * HALF) = w; } }
    }
};
}

namespace da {
constexpr int NW = 8, QBLK = 32, KVBLK = 64;
constexpr int SHM_V = KVBLK * 128 * 2, SHM_K = KVBLK * 64 * 2;
constexpr int OFF_V = 0, OFF_K = 2 * SHM_V, OFF_WS = OFF_K + 2 * SHM_K, SHM_TOTAL = OFF_WS + NW * 64 * 4;
constexpr float THRL = 8.f * LOG2E;
#define KSWZ64(row, colB) ((row) * 128 + ((colB) ^ ((((row) >> 1) & 7) << 4)))
#define SBAR() __builtin_amdgcn_sched_barrier(0)
__device__ __forceinline__ int crow(int r, int hi) { return (r & 3) + 8 * (r >> 2) + 4 * hi; }
__device__ __forceinline__ unsigned cvtpk(float lo, float hi) { unsigned r; asm volatile("v_cvt_pk_bf16_f32 %0, %1, %2" : "=v"(r) : "v"(lo), "v"(hi)); return r; }

__device__ __forceinline__ int v_st(int k, int c) { const int kk = (k & ~0xC) | ((k & 4) << 1) | ((k & 8) >> 1); return ((kk >> 3) * 4 + (c >> 5)) * 512 + ((kk & 7) * 32 + (c & 31)) * 2; }
__device__ __forceinline__ int v_rd_base(int lane) { return ((lane & 3) << 3) | (((lane >> 2) & 3) << 6) | (((lane >> 4) & 1) << 5) | (((lane >> 5) & 1) << 8); }
constexpr int v_rd_off(int d0, int ks, int half) { return d0 * 512 + ks * 4096 + half * 2048; }
template <int OFF> __device__ __forceinline__ s16x4 tr_read(int vb) {
  s16x4 r; asm volatile("ds_read_b64_tr_b16 %0, %1 offset:%2" : "=&v"(r) : "v"(vb), "i"(OFF) : "memory"); return r;
}
struct VFrag { s16x4 l0, h0, l1, h1, l2, h2, l3, h3; };
template <int D0> __device__ __forceinline__ void v_load8(VFrag& f, int vb) {
  f.l0 = tr_read<v_rd_off(D0, 0, 0)>(vb); f.h0 = tr_read<v_rd_off(D0, 0, 1)>(vb); f.l1 = tr_read<v_rd_off(D0, 1, 0)>(vb); f.h1 = tr_read<v_rd_off(D0, 1, 1)>(vb);
  f.l2 = tr_read<v_rd_off(D0, 2, 0)>(vb); f.h2 = tr_read<v_rd_off(D0, 2, 1)>(vb); f.l3 = tr_read<v_rd_off(D0, 3, 0)>(vb); f.h3 = tr_read<v_rd_off(D0, 3, 1)>(vb);
}
#define PVK(L, H) (bf16x8){L[0], L[1], L[2], L[3], H[0], H[1], H[2], H[3]}
__device__ __forceinline__ void v_mma4(f32x16& od, const VFrag& f, bf16x8 pa0, bf16x8 pa1, bf16x8 pa2, bf16x8 pa3) {
  od = __builtin_amdgcn_mfma_f32_32x32x16_bf16(pa0, PVK(f.l0, f.h0), od, 0, 0, 0);
  od = __builtin_amdgcn_mfma_f32_32x32x16_bf16(pa1, PVK(f.l1, f.h1), od, 0, 0, 0);
  od = __builtin_amdgcn_mfma_f32_32x32x16_bf16(pa2, PVK(f.l2, f.h2), od, 0, 0, 0);
  od = __builtin_amdgcn_mfma_f32_32x32x16_bf16(pa3, PVK(f.l3, f.h3), od, 0, 0, 0);
}
__device__ __forceinline__ void pv_d0(f32x16* o, int vb, bf16x8 pa0, bf16x8 pa1, bf16x8 pa2, bf16x8 pa3) {
  VFrag fa, fb;
  v_load8<0>(fa, vb); v_load8<1>(fb, vb);
  asm volatile("s_waitcnt lgkmcnt(8)" ::: "memory"); SBAR();
  v_mma4(o[0], fa, pa0, pa1, pa2, pa3); SBAR();
  v_load8<2>(fa, vb);
  asm volatile("s_waitcnt lgkmcnt(8)" ::: "memory"); SBAR();
  v_mma4(o[1], fb, pa0, pa1, pa2, pa3); SBAR();
  v_load8<3>(fb, vb);
  asm volatile("s_waitcnt lgkmcnt(8)" ::: "memory"); SBAR();
  v_mma4(o[2], fa, pa0, pa1, pa2, pa3);
  asm volatile("s_waitcnt lgkmcnt(0)" ::: "memory"); SBAR();
  v_mma4(o[3], fb, pa0, pa1, pa2, pa3);
}

#define EX4(B_) do { px[(B_)] = __builtin_amdgcn_exp2f(px[(B_)]); px[(B_) + 1] = __builtin_amdgcn_exp2f(px[(B_) + 1]); px[(B_) + 2] = __builtin_amdgcn_exp2f(px[(B_) + 2]); px[(B_) + 3] = __builtin_amdgcn_exp2f(px[(B_) + 3]); } while (0)
__device__ __forceinline__ void pv_d0e(f32x16* o, int vb, bf16x8 pa0, bf16x8 pa1, bf16x8 pa2, bf16x8 pa3, f32x16& px) {
  VFrag fa, fb;
  v_load8<0>(fa, vb); v_load8<1>(fb, vb);
  asm volatile("s_waitcnt lgkmcnt(8)" ::: "memory"); SBAR();
  v_mma4(o[0], fa, pa0, pa1, pa2, pa3); EX4(0); SBAR();
  v_load8<2>(fa, vb);
  asm volatile("s_waitcnt lgkmcnt(8)" ::: "memory"); SBAR();
  v_mma4(o[1], fb, pa0, pa1, pa2, pa3); EX4(4); SBAR();
  v_load8<3>(fb, vb);
  asm volatile("s_waitcnt lgkmcnt(8)" ::: "memory"); SBAR();
  v_mma4(o[2], fa, pa0, pa1, pa2, pa3); EX4(8);
  asm volatile("s_waitcnt lgkmcnt(0)" ::: "memory"); SBAR();
  v_mma4(o[3], fb, pa0, pa1, pa2, pa3); EX4(12);
}
#undef EX4
typedef __bf16 bf16x2_t __attribute__((ext_vector_type(2)));
__device__ __forceinline__ float dot2sq(unsigned w, float c) { const bf16x2_t v = __builtin_bit_cast(bf16x2_t, w); return __builtin_amdgcn_fdot2_f32_bf16(v, v, c, false); }
__device__ __forceinline__ void expA(f32x16& p0) {
#pragma unroll
  for (int r = 0; r < 16; ++r) p0[r] = __builtin_amdgcn_exp2f(p0[r]);
}
__device__ __forceinline__ unsigned cvtpk_b(float lo, float hi) { const f32x2 v = {lo, hi}; const bf16x2_t b = __builtin_convertvector(v, bf16x2_t); return __builtin_bit_cast(unsigned, b); }
__device__ __forceinline__ void finishB(f32x16& p0, f32x16& p1, float& l_reg, bf16x8& pa0, bf16x8& pa1, bf16x8& pa2, bf16x8& pa3) {
#pragma unroll
  for (int r = 0; r < 16; ++r) p1[r] = __builtin_amdgcn_exp2f(p1[r]);
  float ps = 0;
#pragma unroll
  for (int r = 0; r < 16; ++r) ps += p0[r];
#pragma unroll
  for (int r = 0; r < 16; ++r) ps += p1[r];
  { auto rr = __builtin_amdgcn_permlane32_swap(__float_as_uint(ps), __float_as_uint(ps), false, false);
    ps = __uint_as_float(rr[0]) + __uint_as_float(rr[1]); }
  l_reg += ps;
#define PK4(P, BASE, OUT) do { unsigned a0 = cvtpk_b(P[BASE + 0], P[BASE + 1]), a1 = cvtpk_b(P[BASE + 2], P[BASE + 3]);   \
    unsigned b0 = cvtpk_b(P[BASE + 4], P[BASE + 5]), b1 = cvtpk_b(P[BASE + 6], P[BASE + 7]);                              \
    auto r0 = __builtin_amdgcn_permlane32_swap(a0, b0, false, false); auto r1 = __builtin_amdgcn_permlane32_swap(a1, b1, false, false); \
    u32x4 w = {r0[0], r1[0], r0[1], r1[1]}; OUT = *reinterpret_cast<bf16x8*>(&w); } while (0)
  PK4(p0, 0, pa0); PK4(p0, 8, pa1); PK4(p1, 0, pa2); PK4(p1, 8, pa3);
#undef PK4
}
__device__ __forceinline__ void k_pre(bf16x8 (&kf)[8], const char* Ks, int r32, int hi) {
#pragma unroll
  for (int d0 = 0; d0 < 4; ++d0) { const int cb = (d0 * 16 + hi * 8) * 2;
    kf[2 * d0] = *reinterpret_cast<const bf16x8*>(Ks + KSWZ64(r32, cb)); kf[2 * d0 + 1] = *reinterpret_cast<const bf16x8*>(Ks + KSWZ64(32 + r32, cb)); }
}
__device__ __forceinline__ void qkt_k(f32x16& p0, f32x16& p1, const f32x16& pinit, const bf16x8 (&kf)[8], const bf16x8* qr) {
  p0 = pinit; p1 = pinit;
#pragma unroll
  for (int d0 = 0; d0 < 4; ++d0) { p0 = __builtin_amdgcn_mfma_f32_32x32x16_bf16(kf[2 * d0], qr[d0], p0, 0, 0, 0); p1 = __builtin_amdgcn_mfma_f32_32x32x16_bf16(kf[2 * d0 + 1], qr[d0], p1, 0, 0, 0); }
}
__device__ __forceinline__ void qkt_i(f32x16& p0, f32x16& p1, const f32x16& pinit, const char* Ks, const bf16x8* qr, int r32, int hi) {
  p0 = pinit; p1 = pinit;
#pragma unroll
  for (int d0 = 0; d0 < 4; ++d0) { const int cb = (d0 * 16 + hi * 8) * 2;
    bf16x8 b0 = *reinterpret_cast<const bf16x8*>(Ks + KSWZ64(r32, cb));
    bf16x8 b1 = *reinterpret_cast<const bf16x8*>(Ks + KSWZ64(32 + r32, cb));
    p0 = __builtin_amdgcn_mfma_f32_32x32x16_bf16(b0, qr[d0], p0, 0, 0, 0);
    p1 = __builtin_amdgcn_mfma_f32_32x32x16_bf16(b1, qr[d0], p1, 0, 0, 0); }
}
__device__ __forceinline__ void attn_comp(const bf16_t* __restrict__ Qb, const bf16_t* __restrict__ Kh, const bf16_t* __restrict__ Vh, int seq, float kmx, char* lds, f32x16 (&o)[4], const int wv) {
  const int tid = wv * 64 + lane_now();
  const int wid = tid >> 6, lane = tid & 63, r32 = lane & 31, hi = lane >> 5;
  char* V_lds = lds + OFF_V; char* K_lds = lds + OFF_K;
  float* wsb = (float*)(lds + OFF_WS); float* li_l = wsb + wid * 64;
  float l_reg = 0; bf16x8 qr[4];
#pragma unroll
  for (int d = 0; d < 4; ++d) o[d] = f32x16{};
  const bf16_t* Qw = Qb + (long)(wid * QBLK + r32) * LDP + hi * 8;
#pragma unroll
  for (int d0 = 0; d0 < 4; ++d0) qr[d0] = *reinterpret_cast<const bf16x8*>(Qw + d0 * 16);
  float qsq = 0.f;
#pragma unroll
  for (int d0 = 0; d0 < 4; ++d0) { const u32x4 w = *reinterpret_cast<const u32x4*>(&qr[d0]); qsq = dot2sq(w.x, qsq); qsq = dot2sq(w.y, qsq); qsq = dot2sq(w.z, qsq); qsq = dot2sq(w.w, qsq); }
  { auto rr = __builtin_amdgcn_permlane32_swap(__float_as_uint(qsq), __float_as_uint(qsq), false, false); qsq = __uint_as_float(rr[0]) + __uint_as_float(rr[1]); }
  const int sr = tid >> 4, sc = (tid & 15) * 8, vst0 = v_st(sr, sc), vst1 = v_st(32 + sr, sc);
  const int kr = tid >> 3, kc = (tid & 7) * 8, kst = KSWZ64(kr, kc * 2);
  const int vb0 = (int)(uintptr_t)V_lds + v_rd_base(lane);
  struct { bf16x8 vs0, vs1, ks0; } sr_[1];
#define SLOAD(i, k0) do { sr_[i].vs0 = *reinterpret_cast<const bf16x8*>(&Vh[(long)((k0) + sr) * LDP + sc]); sr_[i].vs1 = *reinterpret_cast<const bf16x8*>(&Vh[(long)((k0) + 32 + sr) * LDP + sc]); \
    sr_[i].ks0 = *reinterpret_cast<const bf16x8*>(&Kh[(long)((k0) + kr) * LDP + kc]); } while (0)
#define SWRITE(b, i) do { *(bf16x8*)(V_lds + (b) * SHM_V + vst0) = sr_[i].vs0; *(bf16x8*)(V_lds + (b) * SHM_V + vst1) = sr_[i].vs1; \
    *(bf16x8*)(K_lds + (b) * SHM_K + kst) = sr_[i].ks0; } while (0)
#define SWAIT() asm volatile("s_waitcnt vmcnt(0)" ::: "memory")
  f32x16 pA0, pA1, pB0, pB1; bf16x8 pa0, pa1, pa2, pa3; const int NTL = seq / KVBLK;
  SLOAD(0, 0); asm volatile("s_waitcnt vmcnt(0)" ::: "memory"); SWRITE(0, 0); __syncthreads();
  const float mrow = sqrtf(qsq * kmx) * 1.01f;
  f32x16 pinit;
#pragma unroll
  for (int r = 0; r < 16; ++r) pinit[r] = -mrow;
  SLOAD(0, KVBLK);
  qkt_i(pA0, pA1, pinit, K_lds, qr, r32, hi); expA(pA0);
  SWAIT(); SWRITE(1, 0); __syncthreads();
  for (int j = 1; j + 1 < NTL; j += 2) {
    SLOAD(0, (j + 1) * KVBLK);
    { bf16x8 kf[8]; SBAR(); k_pre(kf, K_lds + SHM_K, r32, hi); SBAR(); qkt_k(pB0, pB1, pinit, kf, qr);
    finishB(pA0, pA1, l_reg, pa0, pa1, pa2, pa3); SBAR(); }
    pv_d0e(o, vb0, pa0, pa1, pa2, pa3, pB0);
    __syncthreads(); SWAIT(); SWRITE(0, 0);
    __syncthreads();
    SLOAD(0, (j + 2) * KVBLK);
    { bf16x8 kf[8]; SBAR(); k_pre(kf, K_lds, r32, hi); SBAR(); qkt_k(pA0, pA1, pinit, kf, qr);
    finishB(pB0, pB1, l_reg, pa0, pa1, pa2, pa3); SBAR(); }
    pv_d0e(o, vb0 + SHM_V, pa0, pa1, pa2, pa3, pA0);
    __syncthreads(); SWAIT(); SWRITE(1, 0);
    __syncthreads();
  }
  SBAR(); qkt_i(pB0, pB1, pinit, K_lds + SHM_K, qr, r32, hi);
  finishB(pA0, pA1, l_reg, pa0, pa1, pa2, pa3); SBAR();
  pv_d0e(o, vb0, pa0, pa1, pa2, pa3, pB0);
  __syncthreads();
  finishB(pB0, pB1, l_reg, pa0, pa1, pa2, pa3); SBAR();
  pv_d0(o, vb0 + SHM_V, pa0, pa1, pa2, pa3);
  if (hi == 0) li_l[r32] = l_reg; asm volatile("s_waitcnt lgkmcnt(0)" ::: "memory");
#pragma unroll
  for (int r = 0; r < 16; ++r) { const float rl = __builtin_amdgcn_rcpf(li_l[crow(r, hi)]);
#pragma unroll
    for (int d0 = 0; d0 < 4; ++d0) o[d0][r] *= rl; }
  __syncthreads();
#undef SLOAD
#undef SWRITE
#undef SWAIT
}

__device__ __forceinline__ void diff_unit(const bf16_t* __restrict__ PROJ, int h, int row0, int seq, float kmx0, float kmx1, float lam, float omli, const float* __restrict__ subln,
                                          float* __restrict__ O1, bf16_t* __restrict__ MIX, char* lds, const int wv) {
  const int tid = wv * 64 + lane_now();
  const int wid = tid >> 6, lane = tid & 63, r32 = lane & 31, hi = lane >> 5;
  f32x16 o[4];
  attn_comp(PROJ + (size_t)row0 * LDP + h * 128, PROJ + 1024 + h * 128, PROJ + 2048 + h * 128, seq, kmx0, lds, o, wv);
  float* O1w = O1 + (size_t)(row0 + wid * QBLK) * 1024 + h * 128 + r32;
#pragma unroll
  for (int r = 0; r < 16; ++r) { const int orow = crow(r, hi);
#pragma unroll
    for (int d0 = 0; d0 < 4; ++d0) O1w[(size_t)orow * 1024 + d0 * 32] = o[d0][r]; }
  attn_comp(PROJ + (size_t)row0 * LDP + h * 128 + 64, PROJ + 1024 + h * 128 + 64, PROJ + 2048 + h * 128, seq, kmx1, lds, o, wv);
  float sw[4];
#pragma unroll
  for (int d0 = 0; d0 < 4; ++d0) sw[d0] = subln[d0 * 32 + r32] * omli;
  bf16_t* Mw = MIX + (size_t)(row0 + wid * QBLK) * DM + h * 128 + r32;
#pragma unroll
  for (int r = 0; r < 16; ++r) { const int orow = crow(r, hi);
    float v[4]; float ss = 0.f;
#pragma unroll
    for (int d0 = 0; d0 < 4; ++d0) { v[d0] = O1w[(size_t)orow * 1024 + d0 * 32] - lam * o[d0][r]; ss += v[d0] * v[d0]; }
    ss = half_sum32(ss);
    const float rs = rsqrtf(ss * (1.f / 128.f) + EPS);
#pragma unroll
    for (int d0 = 0; d0 < 4; ++d0) { const unsigned pk = cvtpk(v[d0] * rs * sw[d0], 0.f); Mw[(size_t)orow * DM + d0 * 32] = (bf16_t)(pk & 0xffffu); }
  }
}
}


namespace rt {
using da::crow; using da::cvtpk; using da::v_st; using da::v_rd_base; using da::pv_d0;
#define KSWZ128(row, colB) ((row) * 256 + ((colB) ^ (((row) & 7) << 4)))
constexpr int NCH = 65;
__device__ __forceinline__ s16x4 tr_read_a(int addr) { s16x4 r; asm volatile("ds_read_b64_tr_b16 %0, %1" : "=&v"(r) : "v"(addr) : "memory"); return r; }
#define RT_PK(L, H) (bf16x8){L[0], L[1], L[2], L[3], H[0], H[1], H[2], H[3]}
__device__ __forceinline__ void kv_unit(const bf16_t* __restrict__ PROJ, int h, int k, float lg2f, float lg2r, h16* __restrict__ KV, char* lds, const int wv) {
  const int tid = wv * 64 + lane_now();
  const int wid = tid >> 6, lane = tid & 63, r32 = lane & 31, hi = lane >> 5;
  const int row0 = 256 * k;
  {
    bf16x8 rg[16];
#pragma unroll
    for (int half = 0; half < 2; ++half)
#pragma unroll
      for (int i = 0; i < 8; ++i) { const int p = tid + 512 * i, tok = p >> 4, c8 = (p & 15) * 8;
        rg[half * 8 + i] = *reinterpret_cast<const bf16x8*>(PROJ + (size_t)(row0 + tok) * LDP + (half ? 3072 : 1536) + h * 128 + c8); }
#pragma unroll
    for (int half = 0; half < 2; ++half)
#pragma unroll
      for (int i = 0; i < 8; ++i) { const int p = tid + 512 * i, tok = p >> 4, c8 = (p & 15) * 8;
        *(bf16x8*)(lds + half * 65536 + (tok >> 6) * 16384 + v_st(tok & 63, c8)) = rg[half * 8 + i]; }
  }
  __syncthreads();
  const int dir = wid >> 2, D0a = wid & 3;
  const float lg2 = dir ? lg2r : lg2f;
  f32x16 acc[4];
#pragma unroll
  for (int d = 0; d < 4; ++d) acc[d] = f32x16{};
  const int kb = (int)(uintptr_t)lds + v_rd_base(lane) + D0a * 512, vb = (int)(uintptr_t)lds + 65536 + v_rd_base(lane);
#pragma unroll
  for (int t = 0; t < 4; ++t)
#pragma unroll
    for (int ks = 0; ks < 4; ++ks) {
      const s16x4 kl = tr_read_a(kb + t * 16384 + ks * 4096), kh = tr_read_a(kb + t * 16384 + ks * 4096 + 2048);
      s16x4 vl[4], vh[4];
#pragma unroll
      for (int d0 = 0; d0 < 4; ++d0) { vl[d0] = tr_read_a(vb + t * 16384 + ks * 4096 + d0 * 512); vh[d0] = tr_read_a(vb + t * 16384 + ks * 4096 + d0 * 512 + 2048); }
      asm volatile("s_waitcnt lgkmcnt(0)" ::: "memory"); __builtin_amdgcn_sched_barrier(0);
      const int tok0 = 64 * t + 16 * ks + 8 * hi;
      float w[8];
#pragma unroll
      for (int j = 0; j < 8; ++j) { const int e = dir ? (tok0 + j) : (255 - tok0 - j); w[j] = __builtin_amdgcn_exp2f(lg2 * (float)e); }
      u32x4 aw;
      aw.x = cvtpk(bf2f((unsigned short)kl[0]) * w[0], bf2f((unsigned short)kl[1]) * w[1]); aw.y = cvtpk(bf2f((unsigned short)kl[2]) * w[2], bf2f((unsigned short)kl[3]) * w[3]);
      aw.z = cvtpk(bf2f((unsigned short)kh[0]) * w[4], bf2f((unsigned short)kh[1]) * w[5]); aw.w = cvtpk(bf2f((unsigned short)kh[2]) * w[6], bf2f((unsigned short)kh[3]) * w[7]);
      const bf16x8 af = *reinterpret_cast<bf16x8*>(&aw);
#pragma unroll
      for (int d0 = 0; d0 < 4; ++d0) acc[d0] = __builtin_amdgcn_mfma_f32_32x32x16_bf16(af, RT_PK(vl[d0], vh[d0]), acc[d0], 0, 0, 0);
    }
  h16* out = KV + ((size_t)(dir * 12 + h) * NCH + k) * 16384 + (size_t)(32 * D0a) * 128 + r32;
#pragma unroll
  for (int r = 0; r < 16; ++r)
#pragma unroll
    for (int d0 = 0; d0 < 4; ++d0) out[(size_t)crow(r, hi) * 128 + d0 * 32] = (h16)acc[d0][r];
  __syncthreads();
}
__device__ __forceinline__ void qkt128(f32x16& p0, f32x16& p1, const char* Ks, const bf16x8* qr, int r32, int hi) {
  p0 = f32x16{}; p1 = f32x16{};
#pragma unroll
  for (int d0 = 0; d0 < 8; ++d0) { const int cb = (d0 * 16 + hi * 8) * 2;
    bf16x8 b0 = *reinterpret_cast<const bf16x8*>(Ks + KSWZ128(r32, cb));
    bf16x8 b1 = *reinterpret_cast<const bf16x8*>(Ks + KSWZ128(32 + r32, cb));
    p0 = __builtin_amdgcn_mfma_f32_32x32x16_bf16(b0, qr[d0], p0, 0, 0, 0);
    p1 = __builtin_amdgcn_mfma_f32_32x32x16_bf16(b1, qr[d0], p1, 0, 0, 0); }
}
__device__ __forceinline__ void p_to_frag(const f32x16& p0, const f32x16& p1, bf16x8& pa0, bf16x8& pa1, bf16x8& pa2, bf16x8& pa3) {
#define PK4(P, BASE, OUT) do { unsigned a0 = cvtpk(P[BASE + 0], P[BASE + 1]), a1 = cvtpk(P[BASE + 2], P[BASE + 3]);   \
    unsigned b0 = cvtpk(P[BASE + 4], P[BASE + 5]), b1 = cvtpk(P[BASE + 6], P[BASE + 7]);                              \
    auto r0 = __builtin_amdgcn_permlane32_swap(a0, b0, false, false); auto r1 = __builtin_amdgcn_permlane32_swap(a1, b1, false, false); \
    u32x4 w = {r0[0], r1[0], r0[1], r1[1]}; OUT = *reinterpret_cast<bf16x8*>(&w); } while (0)
  PK4(p0, 0, pa0); PK4(p0, 8, pa1); PK4(p1, 0, pa2); PK4(p1, 8, pa3);
#undef PK4
}
__device__ __forceinline__ void ret_tile(f32x16 (&o)[4], const char* Kt, int vb, const bf16x8* qr, int t, int wid, int r32, int hi, float lg2f, float lg2r) {
  f32x16 p0, p1;
  qkt128(p0, p1, Kt, qr, r32, hi);
  const int i = wid * 32 + r32;
#pragma unroll
  for (int r = 0; r < 16; ++r) {
    const int j0 = 64 * t + crow(r, hi), d0_ = i - j0, d1_ = d0_ - 32;
    const float w0 = d0_ > 0 ? __builtin_amdgcn_exp2f(lg2f * (float)d0_) : (d0_ < 0 ? __builtin_amdgcn_exp2f(lg2r * (float)(-d0_)) : 2.f);
    const float w1 = d1_ > 0 ? __builtin_amdgcn_exp2f(lg2f * (float)d1_) : (d1_ < 0 ? __builtin_amdgcn_exp2f(lg2r * (float)(-d1_)) : 2.f);
    p0[r] *= w0; p1[r] *= w1; }
  bf16x8 pa0, pa1, pa2, pa3;
  p_to_frag(p0, p1, pa0, pa1, pa2, pa3);
  pv_d0(o, vb, pa0, pa1, pa2, pa3);
}
__device__ __forceinline__ void out_unit(const bf16_t* __restrict__ PROJ, int h, int k, float lg2f, float lg2r, const bf16_t* __restrict__ SIN, bf16_t* __restrict__ MIX, char* lds, const int wv) {
  const int tid = wv * 64 + lane_now();
  const int wid = tid >> 6, lane = tid & 63, r32 = lane & 31, hi = lane >> 5;
  const int row0 = 256 * k;
  const int sr = tid >> 4, sc8 = (tid & 15) * 8;
  const bf16_t* Kg = PROJ + (size_t)row0 * LDP + 1536 + h * 128 + sc8; const bf16_t* Vg = PROJ + (size_t)row0 * LDP + 3072 + h * 128 + sc8;
  bf16x8 rs[8], rk[8];
  if (k > 0) {
#pragma unroll
    for (int dir = 0; dir < 2; ++dir) { const bf16_t* Sg = SIN + ((size_t)(dir * 12 + h) * NCH + k) * 16384;
#pragma unroll
      for (int i = 0; i < 4; ++i) { const int p = tid + 512 * i; rs[dir * 4 + i] = *reinterpret_cast<const bf16x8*>(Sg + (size_t)(p >> 4) * 128 + (p & 15) * 8); } }
  }
#pragma unroll
  for (int t = 0; t < 2; ++t) { rk[t * 4 + 0] = *reinterpret_cast<const bf16x8*>(Kg + (size_t)(64 * t + sr) * LDP); rk[t * 4 + 1] = *reinterpret_cast<const bf16x8*>(Kg + (size_t)(64 * t + 32 + sr) * LDP);
    rk[t * 4 + 2] = *reinterpret_cast<const bf16x8*>(Vg + (size_t)(64 * t + sr) * LDP); rk[t * 4 + 3] = *reinterpret_cast<const bf16x8*>(Vg + (size_t)(64 * t + 32 + sr) * LDP); }
  bf16x8 qr[8];
  { const bf16_t* Qw = PROJ + (size_t)(row0 + wid * 32 + r32) * LDP + h * 128 + hi * 8;
#pragma unroll
    for (int d0 = 0; d0 < 8; ++d0) qr[d0] = *reinterpret_cast<const bf16x8*>(Qw + d0 * 16); }
  if (k > 0) {
#pragma unroll
    for (int dir = 0; dir < 2; ++dir)
#pragma unroll
      for (int i = 0; i < 4; ++i) { const int p = tid + 512 * i, srow = p >> 4, c8 = (p & 15) * 8; *(bf16x8*)(lds + dir * 32768 + (srow >> 6) * 16384 + v_st(srow & 63, c8)) = rs[dir * 4 + i]; }
  }
#pragma unroll
  for (int t = 0; t < 2; ++t) { char* B = lds + 65536 + t * 32768;
    *(bf16x8*)(B + KSWZ128(sr, sc8 * 2)) = rk[t * 4 + 0]; *(bf16x8*)(B + KSWZ128(32 + sr, sc8 * 2)) = rk[t * 4 + 1];
    *(bf16x8*)(B + 16384 + v_st(sr, sc8)) = rk[t * 4 + 2]; *(bf16x8*)(B + 16384 + v_st(32 + sr, sc8)) = rk[t * 4 + 3]; }
  __syncthreads();
#pragma unroll
  for (int t = 0; t < 2; ++t) { rk[t * 4 + 0] = *reinterpret_cast<const bf16x8*>(Kg + (size_t)(128 + 64 * t + sr) * LDP); rk[t * 4 + 1] = *reinterpret_cast<const bf16x8*>(Kg + (size_t)(128 + 64 * t + 32 + sr) * LDP);
    rk[t * 4 + 2] = *reinterpret_cast<const bf16x8*>(Vg + (size_t)(128 + 64 * t + sr) * LDP); rk[t * 4 + 3] = *reinterpret_cast<const bf16x8*>(Vg + (size_t)(128 + 64 * t + 32 + sr) * LDP); }
  f32x16 o[4];
#pragma unroll
  for (int d = 0; d < 4; ++d) o[d] = f32x16{};
  const int vb0 = (int)(uintptr_t)lds + v_rd_base(lane);
  if (k > 0) {
#pragma unroll 1
    for (int dir = 0; dir < 2; ++dir) {
      const float lg2 = dir ? lg2r : lg2f; const int i = wid * 32 + r32;
      const float sc = __builtin_amdgcn_exp2f(lg2 * (float)(dir ? (256 - i) : (i + 1)));
      bf16x8 qs[8];
#pragma unroll
      for (int d0 = 0; d0 < 8; ++d0) { const u32x4 w = *reinterpret_cast<const u32x4*>(&qr[d0]); u32x4 z;
        z.x = cvtpk(__uint_as_float(w.x << 16) * sc, __uint_as_float(w.x & 0xffff0000u) * sc); z.y = cvtpk(__uint_as_float(w.y << 16) * sc, __uint_as_float(w.y & 0xffff0000u) * sc);
        z.z = cvtpk(__uint_as_float(w.z << 16) * sc, __uint_as_float(w.z & 0xffff0000u) * sc); z.w = cvtpk(__uint_as_float(w.w << 16) * sc, __uint_as_float(w.w & 0xffff0000u) * sc);
        qs[d0] = *reinterpret_cast<bf16x8*>(&z); }
      pv_d0(o, vb0 + dir * 32768, qs[0], qs[1], qs[2], qs[3]);
      pv_d0(o, vb0 + dir * 32768 + 16384, qs[4], qs[5], qs[6], qs[7]);
    }
  }
  __syncthreads();
#pragma unroll
  for (int t = 0; t < 2; ++t) { char* B = lds + t * 32768;
    *(bf16x8*)(B + KSWZ128(sr, sc8 * 2)) = rk[t * 4 + 0]; *(bf16x8*)(B + KSWZ128(32 + sr, sc8 * 2)) = rk[t * 4 + 1];
    *(bf16x8*)(B + 16384 + v_st(sr, sc8)) = rk[t * 4 + 2]; *(bf16x8*)(B + 16384 + v_st(32 + sr, sc8)) = rk[t * 4 + 3]; }
  ret_tile(o, lds + 65536, vb0 + 65536 + 16384, qr, 0, wid, r32, hi, lg2f, lg2r);
  ret_tile(o, lds + 98304, vb0 + 98304 + 16384, qr, 1, wid, r32, hi, lg2f, lg2r);
  __syncthreads();
  ret_tile(o, lds, vb0 + 16384, qr, 2, wid, r32, hi, lg2f, lg2r);
  ret_tile(o, lds + 32768, vb0 + 32768 + 16384, qr, 3, wid, r32, hi, lg2f, lg2r);
  char* Wt = lds + 65536 + wid * 8192;
  u32x4 gv[8];
#pragma unroll
  for (int i = 0; i < 8; ++i) { const int id = lane + 64 * i; gv[i] = *(const u32x4*)(PROJ + (size_t)(row0 + wid * 32 + (id >> 4)) * LDP + 4608 + h * 128 + (id & 15) * 8); }
#pragma unroll
  for (int r = 0; r < 16; ++r) { const int orow = crow(r, hi);
    float ss = 0.f;
#pragma unroll
    for (int d0 = 0; d0 < 4; ++d0) ss += o[d0][r] * o[d0][r];
    ss = half_sum32(ss);
    const float rs_ = rsqrtf(ss * (1.f / 128.f) + EPS);
#pragma unroll
    for (int d0 = 0; d0 < 4; ++d0) { const unsigned pk = cvtpk(o[d0][r] * rs_, 0.f); *(bf16_t*)(Wt + orow * 256 + (d0 * 32 + r32) * 2) = (bf16_t)(pk & 0xffffu); } }
  asm volatile("s_waitcnt lgkmcnt(0)" ::: "memory"); __builtin_amdgcn_wave_barrier();
#pragma unroll
  for (int i = 0; i < 8; ++i) { const int id = lane + 64 * i, row = id >> 4, c8 = (id & 15) * 8;
    const u32x4 y = *(const u32x4*)(Wt + row * 256 + c8 * 2);
    const size_t grow = (size_t)(row0 + wid * 32 + row);
    const u32x4 g = gv[i];
    u32x4 w;
#define SILUQ(x_) ((x_) * __builtin_amdgcn_rcpf(1.f + __expf(-(x_))))
#define GATE2(Y, G) cvtpk(__uint_as_float((Y) << 16) * SILUQ(__uint_as_float((G) << 16)), __uint_as_float((Y) & 0xffff0000u) * SILUQ(__uint_as_float((G) & 0xffff0000u)))
    w.x = GATE2(y.x, g.x); w.y = GATE2(y.y, g.y); w.z = GATE2(y.z, g.z); w.w = GATE2(y.w, g.w);
#undef GATE2
#undef SILUQ
    *(u32x4*)(MIX + grow * DM + 512 + h * 128 + c8) = w; }
  __syncthreads();
}
__device__ __forceinline__ void na_unit(const bf16_t* __restrict__ PROJ, int h, int qb, const float* __restrict__ rpb_h, bf16_t* __restrict__ MIX, char* lds, const int wv) {
  const int tid = wv * 64 + lane_now();
  const int wid = tid >> 6, lane = tid & 63, r32 = lane & 31, hi = lane >> 5;
  const bool lat = qb >= 0;
  const int row0 = lat ? NCTX + 256 * qb : 0;
  float* wsl = (float*)(lds + 32768) + wid * 64; float* al_l = wsl; float* li_l = wsl + 32;
  float* rpbL = (float*)(lds + 32768 + 2048);
  if (lat && tid < 480) { const int dr = tid >> 5, dc = tid & 31; rpbL[tid] = dc < 31 ? rpb_h[dr * 31 + dc] * LOG2E : 0.f; }
  bf16x8 qr[8];
  { const bf16_t* Qw = PROJ + (size_t)(row0 + wid * 32 + r32) * LDP + 3072 + h * 128 + hi * 8;
#pragma unroll
    for (int d0 = 0; d0 < 8; ++d0) qr[d0] = *reinterpret_cast<const bf16x8*>(Qw + d0 * 16); }
  const int qrow = 4 * qb + (wid >> 1), jq = 32 * (wid & 1) + r32;
  const int r0q = min(max(qrow - 4, 0), 248), c0 = min(max(jq - 8, 0), 48), R0 = min(max(4 * qb - 4, 0), 244);
  const int ntile = lat ? 16 : 4, nloc = lat ? 12 : 0;
  f32x16 o[4];
#pragma unroll
  for (int d = 0; d < 4; ++d) o[d] = f32x16{};
  float m_reg = -1e30f, l_reg = 0.f;
  const int vb0 = (int)(uintptr_t)lds + v_rd_base(lane);
  const int sr = tid >> 4, sc8 = (tid & 15) * 8;
  bf16x8 k0, k1, v0, v1;
#define NA_LOAD(tile_) do { const bool lc_ = (tile_) < nloc; const int krow0_ = lc_ ? NCTX + 64 * (R0 + (tile_)) : 64 * ((tile_) - nloc); \
    const bf16_t* Kg_ = PROJ + (size_t)krow0_ * LDP + 4096 + h * 128; const bf16_t* Vg_ = PROJ + (size_t)krow0_ * LDP + 5120 + h * 128; \
    k0 = *reinterpret_cast<const bf16x8*>(Kg_ + (size_t)sr * LDP + sc8); k1 = *reinterpret_cast<const bf16x8*>(Kg_ + (size_t)(32 + sr) * LDP + sc8); \
    v0 = *reinterpret_cast<const bf16x8*>(Vg_ + (size_t)sr * LDP + sc8); v1 = *reinterpret_cast<const bf16x8*>(Vg_ + (size_t)(32 + sr) * LDP + sc8); } while (0)
  NA_LOAD(0);
#pragma unroll 1
  for (int tile = 0; tile < ntile; ++tile) {
    const bool local = tile < nloc; const int kr = R0 + tile;
    *(bf16x8*)(lds + KSWZ128(sr, sc8 * 2)) = k0; *(bf16x8*)(lds + KSWZ128(32 + sr, sc8 * 2)) = k1;
    *(bf16x8*)(lds + 16384 + v_st(sr, sc8)) = v0; *(bf16x8*)(lds + 16384 + v_st(32 + sr, sc8)) = v1;
    if (tile + 1 < ntile) NA_LOAD(tile + 1);
    __syncthreads();
    const bool active = !local || (kr >= r0q && kr < r0q + 8);
    if (active) {
      f32x16 p0, p1;
      qkt128(p0, p1, lds, qr, r32, hi);
      if (local) {
        const float* bl = rpbL + (kr - qrow + 7) * 32 + 15 - jq;
#pragma unroll
        for (int r = 0; r < 16; ++r) { const int j0 = crow(r, hi), j1 = j0 + 32;
          const bool ok0 = (j0 >= c0) && (j0 < c0 + 16), ok1 = (j1 >= c0) && (j1 < c0 + 16);
          const float b0 = bl[ok0 ? j0 : jq], b1 = bl[ok1 ? j1 : jq];
          p0[r] = ok0 ? p0[r] + b0 : -1e30f; p1[r] = ok1 ? p1[r] + b1 : -1e30f; }
      }
      float pmax = p0[0];
#pragma unroll
      for (int r = 1; r < 16; ++r) pmax = fmaxf(pmax, p0[r]);
#pragma unroll
      for (int r = 0; r < 16; ++r) pmax = fmaxf(pmax, p1[r]);
      { auto rr = __builtin_amdgcn_permlane32_swap(__float_as_uint(pmax), __float_as_uint(pmax), false, false); pmax = fmaxf(__uint_as_float(rr[0]), __uint_as_float(rr[1])); }
      const float mn = fmaxf(m_reg, pmax); const float alpha = __builtin_amdgcn_exp2f(m_reg - mn); m_reg = mn;
      float ps = 0.f;
#pragma unroll
      for (int r = 0; r < 16; ++r) { p0[r] = __builtin_amdgcn_exp2f(p0[r] - mn); p1[r] = __builtin_amdgcn_exp2f(p1[r] - mn); ps += p0[r] + p1[r]; }
      { auto rr = __builtin_amdgcn_permlane32_swap(__float_as_uint(ps), __float_as_uint(ps), false, false); ps = __uint_as_float(rr[0]) + __uint_as_float(rr[1]); }
      l_reg = l_reg * alpha + ps;
      if (hi == 0) al_l[r32] = alpha; asm volatile("s_waitcnt lgkmcnt(0)" ::: "memory");
#pragma unroll
      for (int r = 0; r < 16; ++r) { const float a = al_l[crow(r, hi)];
#pragma unroll
        for (int d = 0; d < 4; ++d) o[d][r] *= a; }
      bf16x8 pa0, pa1, pa2, pa3;
      p_to_frag(p0, p1, pa0, pa1, pa2, pa3);
      pv_d0(o, vb0 + 16384, pa0, pa1, pa2, pa3);
    }
    __syncthreads();
  }
#undef NA_LOAD
  if (hi == 0) li_l[r32] = l_reg; asm volatile("s_waitcnt lgkmcnt(0)" ::: "memory");
  bf16_t* Mw = MIX + (size_t)(row0 + wid * 32) * DM + 1024 + h * 128 + r32;
#pragma unroll
  for (int r = 0; r < 16; ++r) { const int orow = crow(r, hi); const float rl = __builtin_amdgcn_rcpf(li_l[orow]);
#pragma unroll
    for (int d0 = 0; d0 < 4; ++d0) { const unsigned pk = cvtpk(o[d0][r] * rl, 0.f); Mw[(size_t)orow * DM + d0 * 32] = (bf16_t)(pk & 0xffffu); } }
  __syncthreads();
}
}

#define XB_TMO      128
#define XB_XCNT(j)  (256  + 64 * (j))
#define XB_XSUB(j)  (1280 + 64 * (j))
#define XB_XGEN(j)  (2304 + 64 * (j))
#define XB_TOP      3328
#define XB_TOPGEN   3392
#define XCD_BAR_WORDS 3456
#define XB_SPIN_CAP (1u << 22)
__device__ __forceinline__ unsigned xb_ld(unsigned* p)              { return __hip_atomic_load(p, __ATOMIC_RELAXED, __HIP_MEMORY_SCOPE_AGENT); }
__device__ __forceinline__ unsigned xb_add(unsigned* p, unsigned v) { return __hip_atomic_fetch_add(p, v, __ATOMIC_RELAXED, __HIP_MEMORY_SCOPE_AGENT); }
__device__ __forceinline__ unsigned xb_xcc_id() { return (unsigned)__builtin_amdgcn_s_getreg((3 << 11) | 20) & 0xFu; }
#define XB_SPIN(cond, bar) do { unsigned _sp = 0; while (cond) { __builtin_amdgcn_s_sleep(1); \
    if ((++_sp & 255u) == 0u) { if (xb_ld(&(bar)[XB_TMO])) break; if (_sp > XB_SPIN_CAP) { atomicAdd(&(bar)[XB_TMO], 1u); break; } } } } while (0)
struct XcdBarrier { unsigned* bar; unsigned x; volatile LAS unsigned* st; };
__device__ __forceinline__ XcdBarrier xcd_barrier_post(unsigned* bar, volatile LAS unsigned* st) {
    XcdBarrier b; b.bar = bar; b.x = xb_xcc_id(); b.st = st;
    if (threadIdx.x == 0) (void)xb_add(&bar[XB_XCNT(b.x)], 1u);
    return b;
}
__device__ __forceinline__ void xcd_barrier_complete(unsigned* bar, unsigned x, unsigned& nloc, unsigned& nx) {
    const unsigned G = gridDim.x * gridDim.y * gridDim.z;
    unsigned sum, cnt, mine, sp = 0u;
    for (;;) {
        sum = 0u; cnt = 0u; mine = 0u;
#pragma unroll
        for (unsigned j = 0; j < 16; ++j) { const unsigned c = xb_ld(&bar[XB_XCNT(j)]); sum += c; cnt += (c > 0u) ? 1u : 0u; mine = (j == x) ? c : mine; }
        if (sum == G) break;
        __builtin_amdgcn_s_sleep(1);
        if ((++sp & 255u) == 0u) { if (xb_ld(&bar[XB_TMO])) break; if (sp > XB_SPIN_CAP) { atomicAdd(&bar[XB_TMO], 1u); break; } }
    }
    nloc = mine > 0u ? mine : 1u; nx = cnt > 0u ? cnt : 1u;
}
__device__ __forceinline__ void xcd_barrier(const XcdBarrier& b) {
    asm volatile("s_waitcnt vmcnt(0)" ::: "memory");
    __syncthreads();
    if (threadIdx.x == 0) {
        unsigned* bar = b.bar;
        __builtin_amdgcn_s_waitcnt(0);
        unsigned nloc = b.st[0], nx = b.st[1];
        if (nloc == 0u) { xcd_barrier_complete(bar, b.x, nloc, nx); b.st[0] = nloc; b.st[1] = nx; }
        const unsigned old = xb_add(&bar[XB_XSUB(b.x)], 1u);
        const unsigned gen = old / nloc;
        if (old + 1u == (gen + 1u) * nloc) {
            __builtin_amdgcn_fence(__ATOMIC_RELEASE, "agent");
            asm volatile("s_waitcnt vmcnt(0)" ::: "memory");
            const unsigned og = xb_add(&bar[XB_TOP], 1u);
            const unsigned tg = og / nx;
            if (og + 1u == (tg + 1u) * nx) xb_add(&bar[XB_TOPGEN], 1u);
            else XB_SPIN(xb_ld(&bar[XB_TOPGEN]) == tg, bar);
            __builtin_amdgcn_fence(__ATOMIC_ACQUIRE, "agent");
            xb_add(&bar[XB_XGEN(b.x)], 1u);
            asm volatile("s_waitcnt vmcnt(0)" ::: "memory");
        } else {
            XB_SPIN(xb_ld(&bar[XB_XGEN(b.x)]) == gen, bar);
            __builtin_amdgcn_fence(__ATOMIC_ACQUIRE, "agent");
            asm volatile("s_waitcnt vmcnt(0)" ::: "memory");
        }
    }
    __syncthreads();
}

struct Frame {
    LAS unsigned char* lds; char* ldsg;
    int wave, vcu, G, gw, NGW;
};

template <int MODE>
__device__ __forceinline__ void transpose_item(const float* __restrict__ W, int K, int N, bf16_t* __restrict__ WT, LAS float* scr, int item, int lane) {
    const int nblk = N / 32, kb = item / nblk, nb = item % nblk, k0 = 64 * kb, n0 = 32 * nb;
#pragma unroll 8
    for (int i = 0; i < 32; ++i) { const int kk = 2 * i + (lane >> 5); scr[kk * 33 + (lane & 31)] = W[(size_t)(k0 + kk) * N + n0 + (lane & 31)]; }
    LDS_WAIT(); asm volatile("" ::: "memory");
    int d0;
    if (MODE == 1) { const int half = n0 >= DFF ? 1 : 0, j0 = n0 - half * DFF; d0 = (j0 >> 7) * 256 + half * 128 + (j0 & 127); } else d0 = n0;
    const int c = lane & 7;
#pragma unroll
    for (int j = 0; j < 4; ++j) { const int n = (lane >> 3) + 8 * j; const LAS float* s = scr + (8 * c) * 33 + n;
        u32x4 o; o.x = cvt_pk_bf16(s[0 * 33], s[1 * 33]); o.y = cvt_pk_bf16(s[2 * 33], s[3 * 33]); o.z = cvt_pk_bf16(s[4 * 33], s[5 * 33]); o.w = cvt_pk_bf16(s[6 * 33], s[7 * 33]);
        *(u32x4*)(WT + (size_t)(d0 + n) * K + k0 + 8 * c) = o; }
    LDS_WAIT(); asm volatile("" ::: "memory");
}

struct Args { const float* in[31]; float* out; unsigned char* ws; int ph_lo, ph_hi, li, pad; };
enum { I_X = 0, I_C, I_CTX, I_CCTX, I_ADAW, I_ADAB, I_N1W, I_N2W, I_W13, I_W2, I_EWIN, I_EWOUT, I_LQ1, I_LK1, I_LQ2, I_LK2, I_SUBLN, I_RPB,
       I_OWIN, I_OWOUT, I_LAMRE, I_LAMIM, I_BRE, I_BIM, I_CRE, I_CIM, I_LOGSTEP, I_S5D, I_WGLU, I_DECAY, I_FNW };
constexpr int PH_PER_LAYER = 10, P_FINAL = 1 + 4 * PH_PER_LAYER, NPHASE = P_FINAL + 1;

typedef __attribute__((address_space(4))) const unsigned char* kaptr_t;
__device__ __forceinline__ const float* ldin(int i) {
    kaptr_t ka = (kaptr_t)__builtin_amdgcn_kernarg_segment_ptr();
    unsigned off = (unsigned)i * 8u; asm volatile("" : "+s"(off));
    const unsigned long long pv = *(const unsigned long long __attribute__((address_space(4)))*)(ka + off);
    return (const float*)(const GAS float*)pv;
}
__global__ void __launch_bounds__(512, 2) fwd(Args args) {
    extern __shared__ __attribute__((aligned(16))) unsigned char lds_raw[];
    Frame F;
    F.lds = (LAS unsigned char*)lds_raw; F.ldsg = (char*)lds_raw;
    F.wave = __builtin_amdgcn_readfirstlane((int)threadIdx.x >> 6);
    F.G = gridDim.x; { const int bx = blockIdx.x; F.vcu = (F.G % 8 == 0) ? (bx % 8) * (F.G / 8) + bx / 8 : bx; }
    F.gw = F.vcu * 8 + F.wave; F.NGW = F.G * 8;
    unsigned char* ws = (unsigned char*)ldin(32);
    unsigned* ctl = (unsigned*)(ws + WS_CTL);
    for (int u = threadIdx.x; u < (LDS_BYTES - LDSCTL_OFF) / 4; u += 512) ((LAS unsigned*)(F.lds + LDSCTL_OFF))[u] = 0u;
    __syncthreads();
    const int lo = args.ph_lo, hi = args.ph_hi;
    volatile LAS unsigned* MISC = (volatile LAS unsigned*)(F.lds + MISC_OFF);
    XcdBarrier bar; bar.bar = ctl + CW_BAR + args.li * BAR_STRIDE; bar.x = 0; bar.st = nullptr;
    if (hi - lo > 1) bar = xcd_barrier_post(ctl + CW_BAR + args.li * BAR_STRIDE, MISC + 8);
#define IN(k) (lo <= (k) && (k) < hi)
#define SEAM(k) do { if (IN(k) && IN((k) + 1)) xcd_barrier(bar); } while (0)

#define MOD ((float*)(wsp + WS_MOD))
#define ROPE ((float*)(wsp + WS_ROPE))
#define LAMV ((float*)(wsp + WS_LAM))
#define XW ((h16*)(wsp + WS_XW))
#define Hb ((bf16_t*)(wsp + WS_H))
#define PROJ ((bf16_t*)(wsp + WS_PROJ))
#define ACT ((bf16_t*)(wsp + WS_PROJ))
#define MIX ((bf16_t*)(wsp + WS_MIX))
#define Ub ((float*)(wsp + WS_U))
#define Y2 ((float*)(wsp + WS_Y2))
#define ORb ((float*)(wsp + WS_OR))
#define O1 ((float*)(wsp + WS_O1))
#define KVb ((h16*)(wsp + WS_OR))
#define SINb ((bf16_t*)(wsp + WS_OR + 100 * MiB))
#define UCb ((bf16_t*)(wsp + WS_UC))
#define A2b ((bf16_t*)(wsp + WS_A2))
#define Eb ((float*)(wsp + WS_E))
#define YGb ((bf16_t*)(wsp + WS_YG))
#define W1Tb ((bf16_t*)(wsp + WS_W1T))
#define W2Tb ((bf16_t*)(wsp + WS_W2T))
#define WGTb ((bf16_t*)(wsp + WS_WGT))
#define SLAB ((float*)(wsp + WS_O1))
#define modL (MOD + (size_t)(L * 2) * 12288)
#define PH_BEGIN unsigned long long wsi_ = (unsigned long long)ws; asm volatile("" : "+s"(wsi_)); unsigned char* wsp = (unsigned char*)(GAS unsigned char*)wsi_; \
    int pG = F.G, pvcu = F.vcu, pwave = F.wave; asm volatile("" : "+s"(pG), "+s"(pvcu), "+s"(pwave)); const int pgw = pvcu * 8 + pwave, pNGW = pG * 8; (void)pgw; (void)pNGW; \
    const int plane = lane_now(); const int ptid = pwave * 64 + plane; (void)ptid;

    if (IN(0)) { PH_BEGIN
        {
            const float* cv = ldin(I_C); const float* ccv = ldin(I_CCTX);
            LAS f32x4* red = (LAS f32x4*)F.lds;
            const int jc = ptid & 31, kq = ptid >> 5;
            for (int it = blockIdx.x; it < 4 * 96; it += pG) {
                const int L = it / 96, slab = it % 96;
                const float* W = ldin(I_ADAW) + (size_t)L * DM * 12288 + slab * 128 + 4 * jc;
                f32x4 a0 = {0.f, 0.f, 0.f, 0.f}, a1 = {0.f, 0.f, 0.f, 0.f};
#pragma unroll 8
                for (int k = kq; k < DM; k += 16) { const f32x4 w = *(const f32x4*)(W + (size_t)k * 12288); const float s0 = silu_f(cv[k]), s1 = silu_f(ccv[k]); a0 = a0 + w * s0; a1 = a1 + w * s1; }
                red[(0 * 16 + kq) * 32 + jc] = a0; red[(1 * 16 + kq) * 32 + jc] = a1;
                __syncthreads();
                if (ptid < 64) { const int which = ptid >> 5; f32x4 s = {0.f, 0.f, 0.f, 0.f};
#pragma unroll
                    for (int q = 0; q < 16; ++q) s = s + red[(which * 16 + q) * 32 + jc];
                    const f32x4 b = *(const f32x4*)(ldin(I_ADAB) + (size_t)L * 12288 + slab * 128 + 4 * jc);
                    *(f32x4*)(MOD + (size_t)(L * 2 + which) * 12288 + slab * 128 + 4 * jc) = s + b; }
                __syncthreads();
            }
        }
        {
            LAS float* k0 = (LAS float*)F.lds;
            const int b2 = ((int)blockIdx.x + pG - (128 % pG)) % pG;
            for (int it = b2; it < 64; it += pG) {
                const int jl2 = it >> 5, g = it & 31;
                {
                    const int dir = ptid >> 8, cp = (ptid >> 4) & 15, c = ptid & 15;
                    const int pg = (jl2 * 2 + dir) * 32 + g;
                    const float dt = expf(ldin(I_LOGSTEP)[pg]);
                    const float* lre = ldin(I_LAMRE) + pg * 64; const float* lim = ldin(I_LAMIM) + pg * 64;
                    const float* bre = ldin(I_BRE) + (size_t)pg * 64 * 16 + c; const float* bim = ldin(I_BIM) + (size_t)pg * 64 * 16 + c;
                    const float* cre = ldin(I_CRE) + (size_t)(pg * 16 + cp) * 64; const float* cim = ldin(I_CIM) + (size_t)(pg * 16 + cp) * 64;
                    float Kt[16];
#pragma unroll
                    for (int q = 0; q < 16; ++q) Kt[q] = 0.f;
                    for (int p = 0; p < 64; ++p) {
                        const float lr = lre[p], li = lim[p];
                        const float mag = expf(lr * dt); float sn, cs; sincosf(li * dt, &sn, &cs);
                        const float ar = mag * cs, ai = mag * sn, den = lr * lr + li * li, nr = ar - 1.f, ni = ai;
                        const float fr = (nr * lr + ni * li) / den, fi = (ni * lr - nr * li) / den;
                        const float br = bre[p * 16], bi = bim[p * 16];
                        const float bbr = fr * br - fi * bi, bbi = fr * bi + fi * br;
                        const float cr = cre[p], ci = cim[p];
                        const float zr = cr * bbr - ci * bbi, zi = cr * bbi + ci * bbr;
                        float wr_ = 1.f, wi_ = 0.f;
#pragma unroll
                        for (int q = 0; q < 16; ++q) { Kt[q] += zr * wr_ - zi * wi_; const float t2 = wr_ * ar - wi_ * ai; wi_ = wr_ * ai + wi_ * ar; wr_ = t2; }
                    }
                    k0[(dir * 16 + cp) * 16 + c] = Kt[0];
                    __syncthreads();
                    bf16_t* W2 = W2Tb + (size_t)((jl2 * 32 + g) * 256) * 512;
                    if (dir == 0) {
#pragma unroll
                        for (int q = 1; q < 16; ++q) { const bf16_t kv = (bf16_t)(cvt_pk_bf16(Kt[q], 0.f) & 0xffffu);
                            for (int sq = 0; sq + q < 16; ++sq) W2[(size_t)((sq + q) * 16 + cp) * 512 + sq * 16 + c] = kv; }
                        const float dd = (c == cp) ? ldin(I_S5D)[jl2 * 512 + g * 16 + c] : 0.f;
                        const bf16_t kd = (bf16_t)(cvt_pk_bf16(Kt[0] + k0[(16 + cp) * 16 + c] + dd, 0.f) & 0xffffu);
                        for (int t = 0; t < 16; ++t) W2[(size_t)(t * 16 + cp) * 512 + t * 16 + c] = kd;
                    } else {
#pragma unroll
                        for (int q = 1; q < 16; ++q) { const bf16_t kv = (bf16_t)(cvt_pk_bf16(Kt[q], 0.f) & 0xffffu);
                            for (int t = 0; t + q < 16; ++t) W2[(size_t)(t * 16 + cp) * 512 + (t + q) * 16 + c] = kv; }
                    }
                }
                if (ptid < 128) {
                    const int dir = ptid >> 6, p = ptid & 63;
                    const int pg = (jl2 * 2 + dir) * 32 + g;
                    const float dt = expf(ldin(I_LOGSTEP)[pg]);
                    const float lr = ldin(I_LAMRE)[pg * 64 + p], li = ldin(I_LAMIM)[pg * 64 + p];
                    const float mag = expf(lr * dt); float sn, cs; sincosf(li * dt, &sn, &cs);
                    const float ar = mag * cs, ai = mag * sn, den = lr * lr + li * li, nr = ar - 1.f, ni = ai;
                    const float fr = (nr * lr + ni * li) / den, fi = (ni * lr - nr * li) / den;
                    float pr[17], pi[17]; pr[0] = 1.f; pi[0] = 0.f;
#pragma unroll
                    for (int q = 1; q < 17; ++q) { pr[q] = pr[q - 1] * ar - pi[q - 1] * ai; pi[q] = pr[q - 1] * ai + pi[q - 1] * ar; }
                    bf16_t* W1r = W1Tb + (size_t)((jl2 * 32 + g) * 256 + dir * 128 + 2 * p) * 256;
                    const float* bre = ldin(I_BRE) + (size_t)(pg * 64 + p) * 16; const float* bim = ldin(I_BIM) + (size_t)(pg * 64 + p) * 16;
#pragma unroll
                    for (int c = 0; c < 16; ++c) { const float br = bre[c], bi = bim[c]; const float bbr = fr * br - fi * bi, bbi = fr * bi + fi * br;
#pragma unroll
                        for (int t = 0; t < 16; ++t) { const float per = dir ? pr[t] : pr[15 - t], pei = dir ? pi[t] : pi[15 - t]; const float vr = per * bbr - pei * bbi, vi = per * bbi + pei * bbr;
                            W1r[t * 16 + c] = (bf16_t)(cvt_pk_bf16(vr, 0.f) & 0xffffu); W1r[256 + t * 16 + c] = (bf16_t)(cvt_pk_bf16(vi, 0.f) & 0xffffu); } }
                    bf16_t* W2 = W2Tb + (size_t)((jl2 * 32 + g) * 256) * 512 + 256 + dir * 128 + 2 * p;
                    const float* cre = ldin(I_CRE) + (size_t)(pg * 16) * 64 + p; const float* cim = ldin(I_CIM) + (size_t)(pg * 16) * 64 + p;
#pragma unroll
                    for (int cp = 0; cp < 16; ++cp) { const float cr = cre[cp * 64], ci = cim[cp * 64];
#pragma unroll
                        for (int t = 0; t < 16; ++t) { const float per = dir ? pr[16 - t] : pr[t + 1], pei = dir ? pi[16 - t] : pi[t + 1]; const float zr = cr * per - ci * pei, zi = cr * pei + ci * per;
                            *(unsigned*)(W2 + (size_t)(t * 16 + cp) * 512) = cvt_pk_bf16(zr, -zi); } }
                }
                __syncthreads();
            }
        }
        {
            LAS float* scr = (LAS float*)(F.lds + pwave * 16384);
            constexpr int IT_IN_E = 32 * (NIN_E / 32), IT_IN_O = 32 * (NIN_O / 32), IT_OUT = 32 * 64, IT_13 = 32 * (2 * DFF / 32), IT_2 = (DFF / 64) * 64;
            constexpr int IT_LAYER_E = IT_IN_E + IT_OUT + IT_13 + IT_2, IT_LAYER_O = IT_IN_O + IT_OUT + IT_13 + IT_2;
            constexpr int IT_TR = 2 * IT_LAYER_E + 2 * IT_LAYER_O;
            constexpr int IT_ROPE = 64, IT_XW = NCTX, IT_LAM = 1, IT_WG = 2 * 128;
            constexpr int IT_ALL = IT_TR + IT_ROPE + IT_XW + IT_LAM + IT_WG;
            for (int it = pgw; it < IT_ALL; it += pNGW) {
                int r = it;
                if (r < IT_TR) {
                    const int pair = r / (IT_LAYER_E + IT_LAYER_O); r -= pair * (IT_LAYER_E + IT_LAYER_O);
                    int L, odd; if (r < IT_LAYER_E) { L = 2 * pair; odd = 0; } else { L = 2 * pair + 1; odd = 1; r -= IT_LAYER_E; }
                    const int itin = odd ? IT_IN_O : IT_IN_E, nin = odd ? NIN_O : NIN_E;
                    if (r < itin) { const float* W = odd ? ldin(I_OWIN) + (size_t)pair * DM * NIN_O : ldin(I_EWIN) + (size_t)pair * DM * NIN_E;
                        transpose_item<0>(W, DM, nin, (bf16_t*)(ws + WS_WIN + (size_t)L * 26 * MiB), scr, r, plane); continue; } r -= itin;
                    if (r < IT_OUT) { const float* W = (odd ? ldin(I_OWOUT) : ldin(I_EWOUT)) + (size_t)pair * DM * DM;
                        transpose_item<0>(W, DM, DM, (bf16_t*)(ws + WS_WOUT + (size_t)L * 8 * MiB), scr, r, plane); continue; } r -= IT_OUT;
                    if (r < IT_13) { transpose_item<1>(ldin(I_W13) + (size_t)L * DM * 2 * DFF, DM, 2 * DFF, (bf16_t*)(ws + WS_W13 + (size_t)L * 44 * MiB), scr, r, plane); continue; } r -= IT_13;
                    transpose_item<0>(ldin(I_W2) + (size_t)L * DFF * DM, DFF, DM, (bf16_t*)(ws + WS_W2 + (size_t)L * 22 * MiB), scr, r, plane); continue;
                }
                r -= IT_TR;
                if (r < IT_ROPE) { const int idx = r * 64 + plane, pos = idx >> 4, f = idx & 15;
                    const float freq = powf(10000.f, -(float)f / 16.f); const float ang = (float)pos * freq; float sn, cs; sincosf(ang, &sn, &cs);
                    ROPE[idx * 2] = cs; ROPE[idx * 2 + 1] = sn; continue; }
                r -= IT_ROPE;
                if (r < IT_XW) { const float* src = ldin(I_CTX) + (size_t)r * DM;
#pragma unroll
                    for (int j = 0; j < 4; ++j) { const int c = 8 * (plane + 64 * j); st8h(XW + (size_t)r * DM + c, *(const f32x4*)(src + c), *(const f32x4*)(src + c + 4)); }
                    continue; }
                r -= IT_XW;
                if (r >= IT_LAM) { r -= IT_LAM; const int j2 = r >> 7; transpose_item<0>(ldin(I_WGLU) + (size_t)j2 * 512 * 512, 512, 512, WGTb + (size_t)j2 * 512 * 512, scr, r & 127, plane); continue; }
                {
                    for (int je = 0; je < 2; ++je) {
                        const float a = wave_sum(ldin(I_LQ1)[je * 64 + plane] * ldin(I_LK1)[je * 64 + plane]);
                        const float b = wave_sum(ldin(I_LQ2)[je * 64 + plane] * ldin(I_LK2)[je * 64 + plane]);
                        const float li = 0.8f - 0.6f * expf(-0.3f * (float)(2 * je));
                        if (plane == 0) { LAMV[je * 2] = expf(a) - expf(b) + li; LAMV[je * 2 + 1] = 1.f - li; }
                    }
                }
            }
        }
    }
    SEAM(0);

    for (int L = 0; L < 4; ++L) {
        const int pb = 1 + L * PH_PER_LAYER;
        const bool odd = (L & 1) != 0; const int jl = L >> 1;
#define NORM_LOAD(F32_, n_, r_) do { const int nl_ = min((n_), NT - 1); \
            if (F32_) { const float* p_ = xin + (size_t)(nl_ - NCTX) * DM + 8 * plane; _Pragma("unroll") for (int j = 0; j < 4; ++j) { r_[2 * j] = *(const u32x4*)(p_ + 512 * j); r_[2 * j + 1] = *(const u32x4*)(p_ + 512 * j + 4); } } \
            else { const h16* p_ = XW + (size_t)nl_ * DM + 8 * plane; _Pragma("unroll") for (int j = 0; j < 4; ++j) r_[j] = *(const u32x4*)(p_ + 512 * j); } } while (0)
#define NORM_CVT(F32_, r_, v_) do { if (F32_) { _Pragma("unroll") for (int j = 0; j < 8; ++j) v_[j] = __builtin_bit_cast(f32x4, r_[(F32_) ? j : 0]); } \
            else { _Pragma("unroll") for (int j = 0; j < 4; ++j) { const f32x8 f_ = __builtin_convertvector(__builtin_bit_cast(h16x8, r_[j]), f32x8); v_[2 * j] = (f32x4){f_[0], f_[1], f_[2], f_[3]}; v_[2 * j + 1] = (f32x4){f_[4], f_[5], f_[6], f_[7]}; } } } while (0)
#define NORM_LATENT(which, F32_) do { int n = NCTX + pgw; \
              u32x4 r1[(F32_) ? 8 : 4], r2[(F32_) ? 8 : 4]; \
              NORM_LOAD(F32_, n, r1); NORM_LOAD(F32_, n + pNGW, r2); \
              while (n < NT) { \
                f32x4 v[8]; NORM_CVT(F32_, r1, v); \
                _Pragma("unroll") for (int j = 0; j < ((F32_) ? 8 : 4); ++j) r1[j] = r2[j]; \
                NORM_LOAD(F32_, n + 2 * pNGW, r2); \
                unsigned long long mvi_ = (unsigned long long)(modL), nwi_ = (unsigned long long)nw; asm volatile("" : "+s"(mvi_), "+s"(nwi_)); const float* mv = (const float*)(const GAS float*)mvi_; const float* nwl = (const float*)(const GAS float*)nwi_; const float* shp = mv + ((which) ? 3 : 0) * DM; const float* scp = mv + ((which) ? 4 : 1) * DM; \
                float ss = 0.f; \
                _Pragma("unroll") for (int j = 0; j < 8; ++j) ss += (v[j].x * v[j].x + v[j].y * v[j].y) + (v[j].z * v[j].z + v[j].w * v[j].w); \
                const float rstd = rsqrtf(wave_sum(ss) * (1.f / DM) + EPS); \
                _Pragma("unroll") for (int j = 0; j < 4; ++j) { const int col = 8 * plane + 512 * j; u32x4 pk; \
                    { const f32x4 w4 = *(const f32x4*)(nwl + col), s4 = *(const f32x4*)(scp + col), h4 = *(const f32x4*)(shp + col); const f32x4 y = v[2 * j] * rstd * w4 * (s4 + 1.f) + h4; pk.x = cvt_pk_bf16(y.x, y.y); pk.y = cvt_pk_bf16(y.z, y.w); } \
                    { const f32x4 w4 = *(const f32x4*)(nwl + col + 4), s4 = *(const f32x4*)(scp + col + 4), h4 = *(const f32x4*)(shp + col + 4); const f32x4 y = v[2 * j + 1] * rstd * w4 * (s4 + 1.f) + h4; pk.z = cvt_pk_bf16(y.x, y.y); pk.w = cvt_pk_bf16(y.z, y.w); } \
                    *(u32x4*)(Hb + (size_t)n * DM + col) = pk; } \
                n += pNGW; \
              } } while (0)
#define NORM_PHASE(which) do { PH_BEGIN \
            const float* nw = ldin((which) ? I_N2W : I_N1W) + (size_t)L * DM; \
            const float* xin = (!(which) && L == 0) ? ldin(I_X) : nullptr;              \
              \
            if (!((which) && L == 3)) { \
                const int nparts = (which) ? 8 : (L > 0 ? 11 : 0); \
                volatile LAS float* red = (volatile LAS float*)F.lds; \
                for (int r = pvcu; r < NCTX; r += pG) { \
                    const int col = 4 * ptid; \
                    const h16x4 hx = *(const h16x4*)(XW + (size_t)r * DM + col); \
                    f32x4 a = __builtin_convertvector(hx, f32x4); \
                    if (nparts > 0) { f32x4 s[11]; const float* sp = SLAB + (size_t)r * DM + col; \
                        _Pragma("unroll") for (int pp = 0; pp < 8; ++pp) s[pp] = *(const f32x4*)(sp + (size_t)pp * NCTX * DM); \
                        _Pragma("unroll") for (int pp = 8; pp < 11; ++pp) s[pp] = *(const f32x4*)(sp + (size_t)(nparts > 8 ? pp : 0) * NCTX * DM); \
                        _Pragma("unroll") for (int pp = 0; pp < 8; ++pp) a = a + s[pp]; \
                        if (nparts > 8) a = a + ((s[8] + s[9]) + s[10]); \
                        *(h16x4*)(XW + (size_t)r * DM + col) = __builtin_convertvector(a, h16x4); } \
                    const float ps = wave_sum((a.x * a.x + a.y * a.y) + (a.z * a.z + a.w * a.w)); \
                    if (plane == 0) red[pwave] = ps; \
                    const float* mv = modL + 12288; const float* shp = mv + ((which) ? 3 : 0) * DM; const float* scp = mv + ((which) ? 4 : 1) * DM; \
                    const f32x4 w4 = *(const f32x4*)(nw + col), s4 = *(const f32x4*)(scp + col), h4 = *(const f32x4*)(shp + col); \
                    __syncthreads(); \
                    const float tot = ((red[0] + red[1]) + (red[2] + red[3])) + ((red[4] + red[5]) + (red[6] + red[7])); \
                    const float rstd = rsqrtf(tot * (1.f / DM) + EPS); \
                    const f32x4 y = a * rstd * w4 * (s4 + 1.f) + h4; \
                    u32x2 pk; pk.x = cvt_pk_bf16(y.x, y.y); pk.y = cvt_pk_bf16(y.z, y.w); \
                    *(u32x2*)(Hb + (size_t)r * DM + col) = pk; \
                    __syncthreads(); \
                } } \
              \
            if (xin != nullptr) NORM_LATENT(which, 1); else NORM_LATENT(which, 0); } while (0)

        if (IN(pb + 0)) { NORM_PHASE(0); }
        SEAM(pb + 0);

        if (IN(pb + 1)) { PH_BEGIN
            if (!odd) {
                pg8::Gemm g{Hb, (const bf16_t*)(ws + WS_WIN + (size_t)L * 26 * MiB), NT, NIN_E, DM, DM, DM};
                pg8::StaticOrder S; S.init(NT / 256, NIN_E / 256, pG, (int)blockIdx.x, 0);
                pg8::EpiEvenIn E{PROJ, ROPE, ctl + CW_KM + jl * 32};
                pg8::gemm_phase<pg8::EpiEvenIn, pg8::StaticOrder, true, true>(F.lds, g, S, E, pwave);

            } else {
                pg8::Gemm g{Hb, (const bf16_t*)(ws + WS_WIN + (size_t)L * 26 * MiB), NT, NIN_O, DM, DM, DM};
                pg8::StaticOrder S; S.init(NT / 256, NIN_O / 256, pG, (int)blockIdx.x, 0);
                pg8::EpiOddIn2 E{PROJ, UCb, A2b};
                pg8::gemm_phase<pg8::EpiOddIn2, pg8::StaticOrder, true, true>(F.lds, g, S, E, pwave);

            }
        }
        SEAM(pb + 1);

        {
        if (IN(pb + 2)) { PH_BEGIN
            if (!odd) {
                const float lam = LAMV[jl * 2], omli = LAMV[jl * 2 + 1];
                const float* subln = ldin(I_SUBLN) + jl * 128;
                for (int ui = pvcu; ui < 520; ui += pG) {
                    int h, row0, seq;
                    if (ui < 512) { h = ui >> 6; row0 = NCTX + (ui & 63) * 256; seq = NT; } else { h = ui - 512; row0 = 0; seq = NCTX; }
                    const float* kmp = (const float*)(ctl + CW_KM) + (jl * 8 + h) * 4;
                    da::diff_unit(PROJ, h, row0, seq, kmp[0] + kmp[1], kmp[2] + kmp[3], lam, omli, subln, O1, MIX, F.ldsg, pwave);
                }
                for (;;) {
                    __syncthreads();
                    if (ptid == 0) MISC[2] = __hip_atomic_fetch_add(ctl + CW_DQ + jl * 32, 1u, __ATOMIC_RELAXED, __HIP_MEMORY_SCOPE_AGENT);
                    __syncthreads();
                    const int ui = (int)MISC[2];
                    if (ui >= 520) break;
                    int h, qb; if (ui < 512) { h = ui >> 6; qb = ui & 63; } else { h = ui - 512; qb = -1; }
                    rt::na_unit(PROJ, h, qb, ldin(I_RPB) + (size_t)(jl * 8 + h) * 15 * 31, MIX, F.ldsg, pwave);
                }
            } else {
                {
                    pg8::Gemm g{UCb, W1Tb + (size_t)jl * 32 * 256 * 256, 32 * 1280, 256, 256, 256, 256};
                    pg8::BatchOrder S{160, pG, (int)blockIdx.x};
                    pg8::EpiS5E E{Eb};
                    pg8::gemm_phase<pg8::EpiS5E, pg8::BatchOrder, true, true>(F.lds, g, S, E, pwave);
                }
                for (int ui = (pvcu + pG - (20 % pG)) % pG; ui < 12 * rt::NCH; ui += pG) {
                    const int h = ui / rt::NCH, k = ui % rt::NCH;
                    const float lgf = -log1pf(expf(-ldin(I_DECAY)[(jl * 2 + 0) * 12 + h])) * LOG2E, lgr = -log1pf(expf(-ldin(I_DECAY)[(jl * 2 + 1) * 12 + h])) * LOG2E;
                    rt::kv_unit(PROJ, h, k, lgf, lgr, KVb, F.ldsg, pwave);
                }
            }
        }
        SEAM(pb + 2);

        if (odd && IN(pb + 3)) { PH_BEGIN
            for (int it = pvcu; it < 64; it += pG) {
                const int dir = it >> 5, g = it & 31, p = plane;
                const int pg = (jl * 2 + dir) * 32 + g;
                const float lr = ldin(I_LAMRE)[pg * 64 + p], li = ldin(I_LAMIM)[pg * 64 + p];
                const float dt = expf(ldin(I_LOGSTEP)[pg]);
                const float mag = expf(16.f * lr * dt); float sn, cs; sincosf(16.f * li * dt, &sn, &cs);
                const float ar = mag * cs, ai = mag * sn;
                const float* Eg = Eb + (size_t)(g * 1280) * 256 + dir * 128 + 2 * p; bf16_t* Hg = A2b + (size_t)(g * 1280) * 512 + 256 + dir * 128 + 2 * p;
                LAS f32x2* segT = (LAS f32x2*)F.lds;
                float hr = 0.f, hi2 = 0.f, pwr = 1.f, pwi = 0.f;
                const int s0 = 130 * pwave;
#define S5ROW(s_) (dir == 0 ? ((s_) < 16 ? (s_) : 240 + (s_)) : ((s_) < 16 ? 15 - (s_) : 1295 - (s_)))
                for (int b = 0; b < 5; ++b) {
                    f32x2 e[26];
#pragma unroll
                    for (int q = 0; q < 26; ++q) { const int s_ = s0 + b * 26 + q; e[q] = *(const f32x2*)(Eg + (size_t)S5ROW(s_) * 256); }
#pragma unroll
                    for (int q = 0; q < 26; ++q) { const float nhr = ar * hr - ai * hi2 + e[q].x, nhi = ar * hi2 + ai * hr + e[q].y; hr = nhr; hi2 = nhi;
                        const float t2 = pwr * ar - pwi * ai; pwi = pwr * ai + pwi * ar; pwr = t2; }
                }
                segT[pwave * 64 + p] = (f32x2){hr, hi2};
                __syncthreads();
                hr = 0.f; hi2 = 0.f;
                for (int v = 0; v < pwave; ++v) { const f32x2 T = segT[v * 64 + p]; const float nhr = pwr * hr - pwi * hi2 + T.x, nhi = pwr * hi2 + pwi * hr + T.y; hr = nhr; hi2 = nhi; }
                for (int b = 0; b < 5; ++b) {
                    f32x2 e[26];
#pragma unroll
                    for (int q = 0; q < 26; ++q) { const int s_ = s0 + b * 26 + q; e[q] = *(const f32x2*)(Eg + (size_t)S5ROW(s_) * 256); }
#pragma unroll
                    for (int q = 0; q < 26; ++q) { const int s_ = s0 + b * 26 + q; *(unsigned*)(Hg + (size_t)S5ROW(s_) * 512) = cvt_pk_bf16(hr, hi2);
                        const float nhr = ar * hr - ai * hi2 + e[q].x, nhi = ar * hi2 + ai * hr + e[q].y; hr = nhr; hi2 = nhi; }
                }
#undef S5ROW
                __syncthreads();
            }
            for (int idx = pvcu * 512 + ptid; idx < 2 * 12 * 4096; idx += pG * 512) {
                const int dir = idx / (12 * 4096), h = (idx >> 12) % 12, e = idx & 4095;
                const float lg2 = -log1pf(expf(-ldin(I_DECAY)[(jl * 2 + dir) * 12 + h])) * LOG2E;
                const float gC = __builtin_amdgcn_exp2f(lg2 * 256.f);
                const size_t base = (size_t)(dir * 12 + h) * rt::NCH * 16384 + (size_t)e * 4;
                const h16* kvp = KVb + base; bf16_t* sp = SINb + base;
                f32x4 S = {0.f, 0.f, 0.f, 0.f};
                const long stp = dir ? -16384 : 16384; const long o1 = dir ? 64 * 16384 : 16384;
#define R2OFF(i_) ((i_) == 0 ? 0L : o1 + (long)((i_) - 1) * stp)
                typedef _Float16 h16x4 __attribute__((ext_vector_type(4)));
                h16x4 kv[13];
#pragma unroll
                for (int q = 0; q < 13; ++q) kv[q] = *(const h16x4*)(kvp + R2OFF(q));
#pragma unroll
                for (int b = 0; b < 5; ++b) {
                    h16x4 nx[13];
                    if (b < 4) {
#pragma unroll
                        for (int q = 0; q < 13; ++q) nx[q] = *(const h16x4*)(kvp + R2OFF((b + 1) * 13 + q));
                    }
#pragma unroll
                    for (int q = 0; q < 13; ++q) { u32x2 pk; pk.x = cvt_pk_bf16(S.x, S.y); pk.y = cvt_pk_bf16(S.z, S.w); *(u32x2*)(sp + R2OFF(b * 13 + q)) = pk; S = S * gC + __builtin_convertvector(kv[q], f32x4); }
                    if (b < 4) {
#pragma unroll
                        for (int q = 0; q < 13; ++q) kv[q] = nx[q];
                    }
                }
#undef R2OFF
            }
        }
        if (odd) SEAM(pb + 3);

        if (odd && IN(pb + 4)) { PH_BEGIN
            {
                pg8::Gemm g{A2b, W2Tb + (size_t)jl * 32 * 256 * 512, 32 * 1280, 256, 512, 512, 512};
                pg8::BatchOrder S{160, pG, (int)blockIdx.x};
                pg8::EpiS5Y E{YGb};
                pg8::gemm_phase<pg8::EpiS5Y, pg8::BatchOrder, true, true>(F.lds, g, S, E, pwave);
            }
            for (int ui = (pvcu + pG - (20 % pG)) % pG; ui < 12 * rt::NCH; ui += pG) {
                const int h = ui / rt::NCH, k = ui % rt::NCH;
                const float lgf = -log1pf(expf(-ldin(I_DECAY)[(jl * 2 + 0) * 12 + h])) * LOG2E, lgr = -log1pf(expf(-ldin(I_DECAY)[(jl * 2 + 1) * 12 + h])) * LOG2E;
                rt::out_unit(PROJ, h, k, lgf, lgr, SINb, MIX, F.ldsg, pwave);
            }
            __syncthreads();
        }
        if (odd) SEAM(pb + 4);
        if (odd && IN(pb + 5)) { PH_BEGIN
            pg8::Gemm g{YGb, WGTb + (size_t)jl * 512 * 512, NT, 512, 512, 512, 512};
            pg8::StaticOrder S; S.init(NT / 256, 2, pG, (int)blockIdx.x, 0);
            pg8::EpiGlu E{YGb, MIX};
            pg8::gemm_phase<pg8::EpiGlu, pg8::StaticOrder, true, true>(F.lds, g, S, E, pwave);
        }
        if (odd) SEAM(pb + 5);
        }

        if (IN(pb + 6)) { PH_BEGIN
            pg8::Gemm g{MIX, (const bf16_t*)(ws + WS_WOUT + (size_t)L * 8 * MiB), NT, DM, DM, DM, DM};
            pg8::SplitOrder S; S.so.init(64, DM / 256, pG, (int)blockIdx.x, 1); S.nmini = L == 3 ? 0 : 64; S.ntp = 4;
            pg8::EpiResid E{XW, L == 0 ? ldin(I_X) : nullptr, modL + 2 * DM, modL + 12288 + 2 * DM, SLAB};
            pg8::gemm_phase<pg8::EpiResid, pg8::SplitOrder, true, true>(F.lds, g, S, E, pwave);

        }
        SEAM(pb + 6);

        if (IN(pb + 7)) { NORM_PHASE(1); }
        SEAM(pb + 7);

        if (IN(pb + 8)) { PH_BEGIN
            pg8::Gemm g{Hb, (const bf16_t*)(ws + WS_W13 + (size_t)L * 44 * MiB), NT, 2 * DFF, DM, DM, DM};
            pg8::StaticOrder S; S.init(L == 3 ? 64 : 65, 2 * DFF / 256, pG, (int)blockIdx.x, L == 3 ? 1 : 0);
            pg8::EpiSwiglu E{ACT};
            pg8::gemm_phase<pg8::EpiSwiglu, pg8::StaticOrder, true, true>(F.lds, g, S, E, pwave);

        }
        SEAM(pb + 8);

        if (IN(pb + 9)) { PH_BEGIN
            pg8::Gemm g{ACT, (const bf16_t*)(ws + WS_W2 + (size_t)L * 22 * MiB), NT, DM, DFF, DFF, DFF};
            pg8::SplitOrder S; S.so.init(64, DM / 256, pG, (int)blockIdx.x, 1); S.nmini = L == 3 ? 0 : 88; S.ntp = 8;
            pg8::EpiResid E{XW, nullptr, modL + 5 * DM, modL + 12288 + 5 * DM, SLAB};
            pg8::gemm_phase<pg8::EpiResid, pg8::SplitOrder, true, true>(F.lds, g, S, E, pwave);

        }
        SEAM(pb + 9);
    }

    if (IN(P_FINAL)) { PH_BEGIN
        const float* fw = ldin(I_FNW);
        { const float* xin = nullptr; (void)xin;
          int n = NCTX + pgw;
          u32x4 r1[4], r2[4];
          NORM_LOAD(0, n, r1); NORM_LOAD(0, n + pNGW, r2);
          while (n < NT) {
            f32x4 v[8]; float ss = 0.f;
            NORM_CVT(0, r1, v);
#pragma unroll
            for (int j = 0; j < 4; ++j) r1[j] = r2[j];
            NORM_LOAD(0, n + 2 * pNGW, r2);
#pragma unroll
            for (int j = 0; j < 8; ++j) ss += (v[j].x * v[j].x + v[j].y * v[j].y) + (v[j].z * v[j].z + v[j].w * v[j].w);
            const float rstd = rsqrtf(wave_sum(ss) * (1.f / DM) + EPS);
            float* orow = (float*)ldin(31) + (size_t)(n - NCTX) * DM + 8 * plane;
#pragma unroll
            for (int j = 0; j < 4; ++j) { const int col = 8 * plane + 512 * j;
                *(f32x4*)(orow + 512 * j) = v[2 * j] * rstd * *(const f32x4*)(fw + col); *(f32x4*)(orow + 512 * j + 4) = v[2 * j + 1] * rstd * *(const f32x4*)(fw + col + 4); }
            n += pNGW;
          } }
    }
#undef IN
#undef SEAM
#undef NORM_PHASE
#undef NORM_LOAD
#undef NORM_CVT
#undef NORM_LATENT
#undef MOD
#undef ROPE
#undef LAMV
#undef XW
#undef Hb
#undef PROJ
#undef ACT
#undef MIX
#undef Ub
#undef Y2
#undef ORb
#undef O1
#undef KVb
#undef SINb
#undef modL
#undef SLAB
#undef UCb
#undef A2b
#undef Eb
#undef YGb
#undef W1Tb
#undef W2Tb
#undef WGTb
#undef PH_BEGIN
}

#ifndef N_LAUNCH_MODE
#define N_LAUNCH_MODE 1
#endif
extern "C" void kernel_launch(void* const* d_in, const int* in_sizes, int n_in, void* d_out, int out_size, void* d_ws, size_t ws_size, hipStream_t stream) {
    static int grid = 0;
    if (grid == 0) {
        if (n_in != 31 || out_size != SEQ * DM || ws_size < WS_END) { fprintf(stderr, "kernel_launch: shape mismatch n_in %d out %d ws %zu (need %zu)\n", n_in, out_size, ws_size, (size_t)WS_END); grid = -1; return; }
        int dev = 0, cus = 0, per_cu = 0;
        if (hipGetDevice(&dev) != hipSuccess || hipDeviceGetAttribute(&cus, hipDeviceAttributeMultiprocessorCount, dev) != hipSuccess) { grid = -1; return; }
        if (hipFuncSetAttribute((const void*)fwd, hipFuncAttributeMaxDynamicSharedMemorySize, LDS_BYTES) != hipSuccess) { fprintf(stderr, "kernel_launch: hipFuncSetAttribute failed\n"); grid = -1; return; }
        if (hipOccupancyMaxActiveBlocksPerMultiprocessor(&per_cu, (const void*)fwd, 512, LDS_BYTES) != hipSuccess || per_cu < 1)
            fprintf(stderr, "kernel_launch: occupancy query reports %d blocks per CU\n", per_cu);
        (void)hipGetLastError();
        grid = cus;
    }
    if (grid < 0) return;
    if (hipMemsetAsync((char*)d_ws + WS_CTL, 0, CTL_ZERO_BYTES, stream) != hipSuccess) return;
    Args a{};
    for (int i = 0; i < 31; ++i) a.in[i] = (const float*)d_in[i];
    a.out = (float*)d_out; a.ws = (unsigned char*)d_ws; a.pad = 0;
    if (N_LAUNCH_MODE == 1) {
        a.ph_lo = 0; a.ph_hi = NPHASE; a.li = 0;
        hipLaunchKernelGGL(fwd, dim3(grid), dim3(512), LDS_BYTES, stream, a);
    } else {
        for (int p = 0; p < NPHASE; ++p) {
            const int k = p == 0 ? -1 : (p - 1) % PH_PER_LAYER; const int L = p == 0 ? -1 : (p - 1) / PH_PER_LAYER;
            if (p != 0 && p != P_FINAL && k >= 3 && k <= 5 && (L & 1) == 0) continue;
            a.ph_lo = p; a.ph_hi = p + 1; a.li = 0;
            hipLaunchKernelGGL(fwd, dim3(grid), dim3(512), LDS_BYTES, stream, a);
        }
    }
    const hipError_t le = hipPeekAtLastError();
    if (le != hipSuccess) fprintf(stderr, "kernel_launch: launch failed: %s\n", hipGetErrorName(le));
}
```

```cpp
#include <hip/hip_runtime.h>
#include <cstdio>
#include <cstdint>

#define LAS __attribute__((address_space(3)))
#define GAS __attribute__((address_space(1)))
typedef unsigned short bf16_t;
typedef short bf16x8 __attribute__((ext_vector_type(8)));
typedef short s16x4 __attribute__((ext_vector_type(4)));
typedef float f32x2 __attribute__((ext_vector_type(2)));
typedef float f32x4 __attribute__((ext_vector_type(4)));
typedef float f32x16 __attribute__((ext_vector_type(16)));
typedef unsigned u32x2 __attribute__((ext_vector_type(2)));
typedef unsigned u32x4 __attribute__((ext_vector_type(4)));

typedef _Float16 h16;
typedef _Float16 h16x8 __attribute__((ext_vector_type(8)));
typedef _Float16 h16x4 __attribute__((ext_vector_type(4)));
typedef float f32x8 __attribute__((ext_vector_type(8)));
__device__ __forceinline__ void ld8h(const h16* p, f32x4& a, f32x4& b) { const h16x8 h = *(const h16x8*)p; const f32x8 f = __builtin_convertvector(h, f32x8); a = (f32x4){f[0], f[1], f[2], f[3]}; b = (f32x4){f[4], f[5], f[6], f[7]}; }
__device__ __forceinline__ void st8h(h16* p, const f32x4 a, const f32x4 b) { const f32x8 f = {a.x, a.y, a.z, a.w, b.x, b.y, b.z, b.w}; *(h16x8*)p = __builtin_convertvector(f, h16x8); }
constexpr int DM = 2048, SEQ = 16384, NCTX = 256, NT = SEQ + NCTX;
constexpr int DFF = 5632, LDP = 6144;
constexpr int NIN_E = 6144, NIN_O = 6656;
constexpr float LOG2E = 1.4426950408889634f;
constexpr float EPS = 1e-6f;

constexpr size_t MiB = 1u << 20;
constexpr size_t WS_CTL = 0, CTL_ZERO_BYTES = 1 * MiB;
constexpr size_t WS_MOD = 1 * MiB;
constexpr size_t WS_ROPE = WS_MOD + 512 * 1024;
constexpr size_t WS_LAM = WS_ROPE + 64 * 1024;
constexpr size_t WS_WIN = 2 * MiB;
constexpr size_t WS_WOUT = WS_WIN + 4 * 26 * MiB;
constexpr size_t WS_W13 = WS_WOUT + 4 * 8 * MiB;
constexpr size_t WS_W2 = WS_W13 + 4 * 44 * MiB;
constexpr size_t WS_XW = WS_W2 + 4 * 22 * MiB;
constexpr size_t WS_H = WS_XW + 130 * MiB;
constexpr size_t WS_PROJ = WS_H + 65 * MiB;
constexpr size_t WS_MIX = WS_PROJ + 195 * MiB;
constexpr size_t WS_U = WS_MIX + 65 * MiB;
constexpr size_t WS_Y2 = WS_U + 33 * MiB;
constexpr size_t WS_OR = WS_Y2 + 65 * MiB;
constexpr size_t WS_O1 = WS_OR + 195 * MiB;
constexpr size_t WS_UC = WS_O1 + 65 * MiB;
constexpr size_t WS_A2 = WS_UC + 20 * MiB;
constexpr size_t WS_E = WS_A2 + 40 * MiB;
constexpr size_t WS_YG = WS_E + 40 * MiB;
constexpr size_t WS_W1T = WS_YG + 17 * MiB;
constexpr size_t WS_W2T = WS_W1T + 8 * MiB;
constexpr size_t WS_WGT = WS_W2T + 16 * MiB;
constexpr size_t WS_END = WS_WGT + 1 * MiB;
static_assert((size_t)NT * DM * 4 <= 130 * MiB && (size_t)NT * LDP * 2 <= 195 * MiB && (size_t)NT * 1536 * 4 * 2 <= 195 * MiB, "ws map");

constexpr int CW_BAR = 4096, BAR_STRIDE = 4096, CW_KM = 131072, CW_DQ = CW_KM + 1024;

constexpr int RING_BYTES = 131072;
constexpr int LDSCTL_OFF = RING_BYTES, MISC_OFF = LDSCTL_OFF + 320;
constexpr int LDS_BYTES = 147456;

__device__ __forceinline__ float bf2f(unsigned short b) { return __uint_as_float((unsigned)b << 16); }
__device__ __forceinline__ unsigned cvt_pk_bf16(float lo, float hi) { unsigned r; asm volatile("v_cvt_pk_bf16_f32 %0, %1, %2" : "=v"(r) : "v"(lo), "v"(hi)); return r; }
template <int M> __device__ __forceinline__ float swz_xor(float v) { return __int_as_float(__builtin_amdgcn_ds_swizzle(__float_as_int(v), (M << 10) | 0x1f)); }
__device__ __forceinline__ float half_sum32(float v) { v += swz_xor<1>(v); v += swz_xor<2>(v); v += swz_xor<4>(v); v += swz_xor<8>(v); v += swz_xor<16>(v); return v; }
__device__ __forceinline__ float wave_sum(float v) {
    v = half_sum32(v);
    auto rr = __builtin_amdgcn_permlane32_swap(__float_as_uint(v), __float_as_uint(v), false, false);
    return __uint_as_float(rr[0]) + __uint_as_float(rr[1]);
}
__device__ __forceinline__ float wave_max(float v) {
    v = fmaxf(v, swz_xor<1>(v)); v = fmaxf(v, swz_xor<2>(v)); v = fmaxf(v, swz_xor<4>(v)); v = fmaxf(v, swz_xor<8>(v)); v = fmaxf(v, swz_xor<16>(v));
    auto rr = __builtin_amdgcn_permlane32_swap(__float_as_uint(v), __float_as_uint(v), false, false);
    return fmaxf(__uint_as_float(rr[0]), __uint_as_float(rr[1]));
}
__device__ __forceinline__ float xor32(float v, int hi) { auto rr = __builtin_amdgcn_permlane32_swap(__float_as_uint(v), __float_as_uint(v), false, false); return __uint_as_float(hi ? rr[0] : rr[1]); }
__device__ __forceinline__ float silu_f(float x) { return x / (1.f + __expf(-x)); }
__device__ __forceinline__ int lane_now() { int l; asm volatile("v_mbcnt_lo_u32_b32 %0, -1, 0\n\tv_mbcnt_hi_u32_b32 %0, -1, %0" : "=v"(l)); return l; }
#define LDS_WAIT() asm volatile("s_waitcnt lgkmcnt(0)" ::: "memory")
#define VM_WAIT() asm volatile("s_waitcnt vmcnt(0)" ::: "memory")

namespace pg8 {
constexpr int BM = 256, BK = 64, HALF = 128, HTB = HALF * BK * 2, STAGE_BYTES = 8 * HTB, NXCD = 8, WGM = 8;
__host__ __device__ __forceinline__ int lds_byte(int r, int c) { const int st = (r >> 4) * 2 + (c >> 5), rr = r & 15, cc = c & 31, ob = rr * 64 + cc * 2; return st * 1024 + (ob ^ (((ob >> 9) & 1) << 5)); }
__host__ __device__ __forceinline__ void stage_rc(int b, int& R, int& C) { const int st = b / 1024, sb = b % 1024, swz = sb ^ (((sb >> 9) & 1) << 5); R = (st >> 1) * 16 + swz / 64; C = (st & 1) * 32 + (swz % 64) / 2; }
__host__ __device__ __forceinline__ int perm32(int rho) { const int n = rho >> 4, i = rho & 15; return 8 * (i >> 2) + 4 * n + (i & 3); }

struct Unit { int pm, pn, kt0, ntu; };
struct Gemm { const bf16_t* A; const bf16_t* Bt; int M, N, K, lda, ldb; };

struct StaticOrder {
    int nM, nN, nwg, G, c, pm0;
    __host__ __device__ void init(int nM_, int nN_, int G_, int c_, int pm0_) { nM = nM_; nN = nN_; nwg = nM * nN; G = G_; c = c_; pm0 = pm0_; }
    __host__ __device__ bool next(int i, Unit& u) const {
        const long L = (long)i * G + c; if (L >= nwg) return false;
        int wgid = (int)L; { const int q = nwg / NXCD, r = nwg % NXCD, xcd = wgid % NXCD, off = wgid / NXCD; wgid = (xcd < r ? xcd * (q + 1) : r * (q + 1) + (xcd - r) * q) + off; }
        const int nig = WGM * nN, gid = wgid / nig, fm = gid * WGM, gsz = (nM - fm) < WGM ? (nM - fm) : WGM;
        u.pm = pm0 + fm + ((wgid % nig) % gsz); u.pn = (wgid % nig) / gsz; u.kt0 = 0; u.ntu = 0; return true;
    }
    __device__ __forceinline__ void a_ready(const Unit&) const {}
    __device__ __forceinline__ void done(const Unit&) const {}
};

struct SplitOrder {
    StaticOrder so; int nmini, ntp;
    __host__ __device__ bool next(int i, Unit& u) const {
        if (so.next(i, u)) return true;
        const long L = (long)i * so.G + so.c - (long)(((so.nwg + so.G - 1) / so.G) * so.G);
        if (L < 0 || L >= nmini) return false;
        u.pm = 0; u.pn = (int)L & 7; u.kt0 = ((int)L >> 3) * ntp; u.ntu = ntp; return true;
    }
    __device__ __forceinline__ void a_ready(const Unit&) const {}
    __device__ __forceinline__ void done(const Unit&) const {}
};
template <class Epi, class Sched, bool ALIGN_EPI = false, bool SP2 = false>
__device__ __forceinline__ void gemm_phase(LAS unsigned char* lds, const Gemm g, const Sched& S, const Epi& E, const int wv) {
    const int wid = wv, lane = lane_now(), tid = wid * 64 + lane;
    const int wr = wid >> 2, wc = wid & 3, fr = lane & 15, fq = lane >> 4;
    const int K = g.K, nt = K / BK;
    unsigned voffA[2], voffB[2];
#pragma unroll
    for (int i = 0; i < 2; ++i) { int R, C; stage_rc(tid * 16 + i * 8192, R, C); const int Rb = Epi::PERM ? ((R & ~31) + perm32(R & 31)) : R;
        voffA[i] = (unsigned)(R * K + C) * 2u; voffB[i] = (unsigned)(Rb * K + C) * 2u; }
    const size_t kstep = (size_t)(BK * 2);
    const size_t hA = (size_t)HALF * K * 2;
#define hB hA
#define tA (2 * hA)
#define tB (2 * hA)
    const unsigned ldsw = (unsigned)wid * 1024u;
    const int aoff = lds_byte(wr * 64 + fr, fq * 8), boff = lds_byte(wc * 32 + fr, fq * 8);
#define PG8_SA(b, h) (((b) * 2 + (h)) * HTB)
#define PG8_SB(b, h) ((4 + (b) * 2 + (h)) * HTB)
#define PG8_STAGE(bufoff, gbase, voff) do { _Pragma("unroll") for (int _i = 0; _i < 2; ++_i) \
        __builtin_amdgcn_global_load_lds((const unsigned*)((const char*)(gbase) + (voff)[_i]), (LAS unsigned*)(lds + (bufoff) + ldsw + _i * 8192), 16, 0, 0); } while (0)
#define PG8_LDA(dst, b, h) do { _Pragma("unroll") for (int m = 0; m < 4; ++m) _Pragma("unroll") for (int k = 0; k < 2; ++k) dst[m][k] = *(const LAS bf16x8*)(lds + PG8_SA(b, h) + aoff + m * 2048 + k * 1024); } while (0)
#define PG8_LDB(dst, b, h) do { _Pragma("unroll") for (int n = 0; n < 2; ++n) _Pragma("unroll") for (int k = 0; k < 2; ++k) dst[n][k] = *(const LAS bf16x8*)(lds + PG8_SB(b, h) + boff + n * 2048 + k * 1024); } while (0)
#define PG8_MMA(ai, bj, At, Bt) do { __builtin_amdgcn_s_setprio(1); _Pragma("unroll") for (int m = 0; m < 4; ++m) _Pragma("unroll") for (int n = 0; n < 2; ++n) _Pragma("unroll") for (int k = 0; k < 2; ++k) \
        acc[ai][bj][m][n] = __builtin_amdgcn_mfma_f32_16x16x32_bf16(Bt[n][k], At[m][k], acc[ai][bj][m][n], 0, 0, 0); __builtin_amdgcn_s_setprio(0); } while (0)
#define PG8_WAIT_V(n) asm volatile("s_waitcnt vmcnt(" #n ")" ::: "memory")
#define PG8_WAIT_L(n) asm volatile("s_waitcnt lgkmcnt(" #n ")" ::: "memory")
#define PG8_BAR __builtin_amdgcn_s_barrier()
#define PG8_SCHED __builtin_amdgcn_sched_barrier(0)
    Unit cur, nxt; int ui = 0;
    if (!S.next(0, cur)) return;
    f32x4 acc[2][2][4][2];
#pragma unroll
    for (int a = 0; a < 2; ++a)
#pragma unroll
        for (int b = 0; b < 2; ++b)
#pragma unroll
            for (int m = 0; m < 4; ++m)
#pragma unroll
                for (int n = 0; n < 2; ++n) acc[a][b][m][n] = (f32x4){0.f, 0.f, 0.f, 0.f};
    bf16x8 At[4][2], B0[2][2], B1[2][2];
    const char* cA = (const char*)g.A + (size_t)cur.pm * tA + (size_t)cur.kt0 * kstep; const char* cB = (const char*)g.Bt + (size_t)cur.pn * tB + (size_t)cur.kt0 * kstep;
    S.a_ready(cur);
    if constexpr (SP2) {
        PG8_STAGE(PG8_SB(0, 0), cB, voffB); PG8_STAGE(PG8_SB(0, 1), cB + hB, voffB); PG8_STAGE(PG8_SA(0, 0), cA, voffA); PG8_STAGE(PG8_SA(0, 1), cA + hA, voffA);
        if (wr == 1) PG8_BAR;
        PG8_WAIT_V(2); PG8_BAR;
        PG8_STAGE(PG8_SB(1, 0), cB + kstep, voffB); PG8_STAGE(PG8_SA(1, 0), cA + kstep, voffA); PG8_STAGE(PG8_SB(1, 1), cB + hB + kstep, voffB);
        PG8_WAIT_V(6); PG8_BAR;
    } else {
        PG8_STAGE(PG8_SB(0, 0), cB, voffB); PG8_STAGE(PG8_SA(0, 0), cA, voffA); PG8_STAGE(PG8_SB(0, 1), cB + hB, voffB); PG8_STAGE(PG8_SA(0, 1), cA + hA, voffA);
        if (wr == 1) PG8_BAR;
        PG8_WAIT_V(4); PG8_BAR;
        PG8_STAGE(PG8_SB(1, 0), cB + kstep, voffB); PG8_STAGE(PG8_SA(1, 0), cA + kstep, voffA); PG8_STAGE(PG8_SB(1, 1), cB + hB + kstep, voffB);
        PG8_WAIT_V(6); PG8_BAR;
    }
    for (;;) {
        const bool has_next = S.next(ui + 1, nxt);
        const char* nA = has_next ? (const char*)g.A + (size_t)nxt.pm * tA + (size_t)nxt.kt0 * kstep : cA; const char* nB = has_next ? (const char*)g.Bt + (size_t)nxt.pn * tB + (size_t)nxt.kt0 * kstep : cB;
        const int ntc = cur.ntu > 0 ? cur.ntu : nt;
        for (int t = 0; t < ntc; t += 2) {
            const bool last = (t == ntc - 2);
            const char* a1 = cA + (size_t)(t + 1) * kstep;
            const char* a2 = last ? nA : cA + (size_t)(t + 2) * kstep; const char* b2 = last ? nB : cB + (size_t)(t + 2) * kstep;
            const char* a3 = a2 + kstep; const char* b3 = b2 + kstep;
            if (last && has_next) S.a_ready(nxt);
            if constexpr (SP2) {
            PG8_LDB(B0, 0, 0); PG8_LDB(B1, 0, 1); PG8_SCHED; PG8_LDA(At, 0, 0); PG8_STAGE(PG8_SA(1, 1), a1 + hA, voffA);
            PG8_WAIT_V(8); PG8_WAIT_L(0); PG8_BAR; PG8_MMA(0, 0, At, B0); PG8_MMA(0, 1, At, B1); PG8_BAR; PG8_SCHED;
            PG8_LDA(At, 0, 1); PG8_STAGE(PG8_SB(0, 0), b2, voffB); PG8_STAGE(PG8_SB(0, 1), b2 + hB, voffB); PG8_STAGE(PG8_SA(0, 0), a2, voffA);
            PG8_WAIT_V(8); PG8_WAIT_L(0); PG8_BAR; PG8_MMA(1, 0, At, B0); PG8_MMA(1, 1, At, B1); PG8_BAR; PG8_SCHED;
            PG8_LDB(B0, 1, 0); PG8_LDB(B1, 1, 1); PG8_SCHED; PG8_LDA(At, 1, 0); PG8_STAGE(PG8_SA(0, 1), a2 + hA, voffA);
            PG8_WAIT_V(8); PG8_WAIT_L(0); PG8_BAR; PG8_MMA(0, 0, At, B0); PG8_MMA(0, 1, At, B1); PG8_BAR; PG8_SCHED;
            PG8_LDA(At, 1, 1); PG8_STAGE(PG8_SB(1, 0), b3, voffB); PG8_STAGE(PG8_SB(1, 1), b3 + hB, voffB); PG8_STAGE(PG8_SA(1, 0), a3, voffA);
            PG8_WAIT_V(8); PG8_WAIT_L(0); PG8_BAR; PG8_MMA(1, 0, At, B0); PG8_MMA(1, 1, At, B1); PG8_BAR; PG8_SCHED;
            } else {
            PG8_LDB(B0, 0, 0); PG8_SCHED; PG8_LDA(At, 0, 0); PG8_STAGE(PG8_SA(1, 1), a1 + hA, voffA);
            PG8_WAIT_L(8); PG8_BAR; PG8_WAIT_L(0); PG8_MMA(0, 0, At, B0); PG8_BAR; PG8_SCHED;
            PG8_LDB(B1, 0, 1); PG8_STAGE(PG8_SB(0, 0), b2, voffB);
            PG8_BAR; PG8_WAIT_L(0); PG8_MMA(0, 1, At, B1); PG8_BAR;
            PG8_LDA(At, 0, 1); PG8_STAGE(PG8_SA(0, 0), a2, voffA);
            PG8_BAR; PG8_WAIT_L(0); PG8_MMA(1, 0, At, B0); PG8_BAR; PG8_SCHED;
            PG8_STAGE(PG8_SB(0, 1), b2 + hB, voffB);
            PG8_WAIT_V(6); PG8_BAR; PG8_MMA(1, 1, At, B1); PG8_BAR;
            PG8_LDB(B0, 1, 0); PG8_SCHED; PG8_LDA(At, 1, 0); PG8_STAGE(PG8_SA(0, 1), a2 + hA, voffA);
            PG8_WAIT_L(8); PG8_BAR; PG8_WAIT_L(0); PG8_MMA(0, 0, At, B0); PG8_BAR; PG8_SCHED;
            PG8_LDB(B1, 1, 1); PG8_STAGE(PG8_SB(1, 0), b3, voffB);
            PG8_BAR; PG8_WAIT_L(0); PG8_MMA(0, 1, At, B1); PG8_BAR;
            PG8_LDA(At, 1, 1); PG8_STAGE(PG8_SA(1, 0), a3, voffA);
            PG8_BAR; PG8_WAIT_L(0); PG8_MMA(1, 0, At, B0); PG8_BAR; PG8_SCHED;
            PG8_STAGE(PG8_SB(1, 1), b3 + hB, voffB);
            PG8_WAIT_V(6); PG8_BAR; PG8_MMA(1, 1, At, B1); PG8_BAR;
            }
        }
        if constexpr (ALIGN_EPI) { if (wr == 0) PG8_BAR; }
        { const int t2 = lane_now(); E(acc, cur, wr, wc, t2 & 15, t2 >> 4); } S.done(cur);
        if (!has_next) break;
#pragma unroll
        for (int a = 0; a < 2; ++a)
#pragma unroll
            for (int b = 0; b < 2; ++b)
#pragma unroll
                for (int m = 0; m < 4; ++m)
#pragma unroll
                    for (int n = 0; n < 2; ++n) acc[a][b][m][n] = (f32x4){0.f, 0.f, 0.f, 0.f};
        cur = nxt; cA = nA; cB = nB; ++ui;
        if constexpr (ALIGN_EPI) { if (wr == 1) PG8_BAR; }
    }
    PG8_WAIT_V(0);
    if constexpr (!ALIGN_EPI) { if (wr == 0) PG8_BAR; }
    PG8_BAR;
#undef hB
#undef tA
#undef tB
#undef PG8_SA
#undef PG8_SB
#undef PG8_STAGE
#undef PG8_LDA
#undef PG8_LDB
#undef PG8_MMA
#undef PG8_WAIT_V
#undef PG8_WAIT_L
#undef PG8_BAR
#undef PG8_SCHED
}

struct EpiEvenIn {
    static constexpr bool PERM = true;
    bf16_t* P; const float* rope; unsigned* km;
    __device__ __forceinline__ void operator()(const f32x4 (&acc)[2][2][4][2], const Unit& u, int wr, int wc, int fr, int fq) const {
        const int region = u.pn >> 2;
        float kmax2[2] = {0.f, 0.f};
        const bool dorope = (region <= 1) && (u.pm != 0);
        const float sc = region == 0 ? 0.125f * LOG2E : (region == 3 ? 0.08838834764831845f * LOG2E : 1.f);
        const int colbase = u.pn * BM + wc * 32 + 8 * fq;
        const float sgn = (fq & 2) ? 1.f : -1.f;
#pragma unroll
        for (int ai = 0; ai < 2; ++ai)
#pragma unroll
            for (int m = 0; m < 4; ++m) {
                const int row = u.pm * BM + ai * HALF + wr * 64 + m * 16 + fr;
                f32x4 cs[4];
                if (dorope) { const int t = row - NCTX; const int pos = (wc & 1) ? (t & 63) : (t >> 6);
                    const f32x4* tb = (const f32x4*)(rope + (pos * 16 + 8 * (fq & 1)) * 2);
#pragma unroll
                    for (int q = 0; q < 4; ++q) cs[q] = tb[q]; }
#pragma unroll
                for (int bj = 0; bj < 2; ++bj) {
                    f32x4 v0 = acc[ai][bj][m][0], v1 = acc[ai][bj][m][1];
                    if (dorope) {
                        f32x4 p0, p1;
#pragma unroll
                        for (int e = 0; e < 4; ++e) { p0[e] = xor32(v0[e], fq >> 1); p1[e] = xor32(v1[e], fq >> 1); }
                        v0[0] = v0[0] * cs[0][0] + sgn * p0[0] * cs[0][1]; v0[1] = v0[1] * cs[0][2] + sgn * p0[1] * cs[0][3];
                        v0[2] = v0[2] * cs[1][0] + sgn * p0[2] * cs[1][1]; v0[3] = v0[3] * cs[1][2] + sgn * p0[3] * cs[1][3];
                        v1[0] = v1[0] * cs[2][0] + sgn * p1[0] * cs[2][1]; v1[1] = v1[1] * cs[2][2] + sgn * p1[1] * cs[2][3];
                        v1[2] = v1[2] * cs[3][0] + sgn * p1[2] * cs[3][1]; v1[3] = v1[3] * cs[3][2] + sgn * p1[3] * cs[3][3];
                    }
                    v0 = v0 * sc; v1 = v1 * sc;
                    if (region == 1) { float ss = (v0[0] * v0[0] + v0[1] * v0[1]) + (v0[2] * v0[2] + v0[3] * v0[3]) + (v1[0] * v1[0] + v1[1] * v1[1]) + (v1[2] * v1[2] + v1[3] * v1[3]);
                        ss += swz_xor<16>(ss); ss += xor32(ss, fq >> 1); kmax2[bj] = fmaxf(kmax2[bj], ss); }
                    u32x4 w; w.x = cvt_pk_bf16(v0[0], v0[1]); w.y = cvt_pk_bf16(v0[2], v0[3]); w.z = cvt_pk_bf16(v1[0], v1[1]); w.w = cvt_pk_bf16(v1[2], v1[3]);
                    *(u32x4*)(P + (size_t)row * LDP + colbase + bj * HALF) = w;
                }
            }
        if (region == 1) {
#pragma unroll
            for (int bj = 0; bj < 2; ++bj) { const float mx = wave_max(kmax2[bj]);
                if ((fr | fq) == 0) __hip_atomic_fetch_max(km + ((2 * (u.pn - 4) + bj) * 2 + (wc >> 1)) * 2 + (wc & 1), __float_as_uint(mx), __ATOMIC_RELAXED, __HIP_MEMORY_SCOPE_AGENT); }
        }
    }
};
struct EpiResid {
    static constexpr bool PERM = true;
    h16* X; const float* Xin; const float* gate_lat; const float* gate_ctx; float* slab;
    __device__ __forceinline__ void operator()(const f32x4 (&acc)[2][2][4][2], const Unit& u, int wr, int wc, int fr, int fq) const {
        const int colbase = u.pn * BM + wc * 32 + 8 * fq;
        const float* gp = (u.pm == 0 ? gate_ctx : gate_lat) + colbase;
        f32x4 g[2][2];
#pragma unroll
        for (int bj = 0; bj < 2; ++bj) { g[bj][0] = *(const f32x4*)(gp + bj * HALF); g[bj][1] = *(const f32x4*)(gp + bj * HALF + 4); }
        if (u.ntu > 0) {
#pragma unroll
            for (int ai = 0; ai < 2; ++ai)
#pragma unroll
                for (int m = 0; m < 4; ++m) { const int row = ai * HALF + wr * 64 + m * 16 + fr;
#pragma unroll
                    for (int bj = 0; bj < 2; ++bj) { float* sp = slab + ((size_t)(u.kt0 / u.ntu) * NCTX + row) * DM + colbase + bj * HALF;
                        *(f32x4*)sp = g[bj][0] * acc[ai][bj][m][0]; *(f32x4*)(sp + 4) = g[bj][1] * acc[ai][bj][m][1]; } }
            return;
        }
#pragma unroll
        for (int ai = 0; ai < 2; ++ai) {
            f32x4 xv[4][2][2];
#pragma unroll
            for (int m = 0; m < 4; ++m) { const size_t row = (size_t)(u.pm * BM + ai * HALF + wr * 64 + m * 16 + fr);
#pragma unroll
                for (int bj = 0; bj < 2; ++bj) {
                    if (Xin != nullptr) { const float* xp = Xin + (row - NCTX) * DM + colbase + bj * HALF; xv[m][bj][0] = *(const f32x4*)xp; xv[m][bj][1] = *(const f32x4*)(xp + 4); }
                    else ld8h(X + row * DM + colbase + bj * HALF, xv[m][bj][0], xv[m][bj][1]); } }
            asm volatile("" ::: "memory");
#pragma unroll
            for (int m = 0; m < 4; ++m) { h16* xp = X + (size_t)(u.pm * BM + ai * HALF + wr * 64 + m * 16 + fr) * DM + colbase;
#pragma unroll
                for (int bj = 0; bj < 2; ++bj) st8h(xp + bj * HALF, xv[m][bj][0] + g[bj][0] * acc[ai][bj][m][0], xv[m][bj][1] + g[bj][1] * acc[ai][bj][m][1]); }
        }
    }
};
struct EpiSwiglu {
    static constexpr bool PERM = true;
    bf16_t* ACT;
    __device__ __forceinline__ void operator()(const f32x4 (&acc)[2][2][4][2], const Unit& u, int wr, int wc, int fr, int fq) const {
        const int colbase = u.pn * HALF + wc * 32 + 8 * fq;
#pragma unroll
        for (int ai = 0; ai < 2; ++ai)
#pragma unroll
            for (int m = 0; m < 4; ++m) {
                const int row = u.pm * BM + ai * HALF + wr * 64 + m * 16 + fr;
                float r[8];
#pragma unroll
                for (int n = 0; n < 2; ++n)
#pragma unroll
                    for (int e = 0; e < 4; ++e) { const float a = acc[ai][0][m][n][e], b = acc[ai][1][m][n][e]; r[n * 4 + e] = a * __builtin_amdgcn_rcpf(1.f + __expf(-a)) * b; }
                u32x4 w; w.x = cvt_pk_bf16(r[0], r[1]); w.y = cvt_pk_bf16(r[2], r[3]); w.z = cvt_pk_bf16(r[4], r[5]); w.w = cvt_pk_bf16(r[6], r[7]);
                *(u32x4*)(ACT + (size_t)row * DFF + colbase) = w;
            }
    }
};

struct BatchOrder {
    int nunits, G, c;
    __host__ __device__ bool next(int i, Unit& u) const { const int L = i * G + c; if (L >= nunits) return false; u.pm = L; u.pn = L / 5; u.kt0 = 0; u.ntu = 0; return true; }
    __device__ __forceinline__ void a_ready(const Unit&) const {}
    __device__ __forceinline__ void done(const Unit&) const {}
};
struct EpiOddIn2 {
    static constexpr bool PERM = true;
    bf16_t* P; bf16_t* UC; bf16_t* A2;
    __device__ __forceinline__ void operator()(const f32x4 (&acc)[2][2][4][2], const Unit& u, int wr, int wc, int fr, int fq) const {
        const int colbase = u.pn * BM + wc * 32 + 8 * fq;
        const float sc = (u.pn >= 8 && u.pn < 14) ? 0.08838834764831845f : 1.f;
#pragma unroll
        for (int ai = 0; ai < 2; ++ai)
#pragma unroll
            for (int m = 0; m < 4; ++m) {
                const int row = u.pm * BM + ai * HALF + wr * 64 + m * 16 + fr;
                const int R = (row < NCTX) ? (row >> 4) : (row >> 4) + 240, t = row & 15;
#pragma unroll
                for (int bj = 0; bj < 2; ++bj) {
                    f32x4 v0 = acc[ai][bj][m][0] * sc, v1 = acc[ai][bj][m][1] * sc;
                    u32x4 w; w.x = cvt_pk_bf16(v0[0], v0[1]); w.y = cvt_pk_bf16(v0[2], v0[3]); w.z = cvt_pk_bf16(v1[0], v1[1]); w.w = cvt_pk_bf16(v1[2], v1[3]);
                    if (u.pn < 2) { const int ch = colbase + bj * HALF, g = ch >> 4, c0 = ch & 15;
                        *(u32x4*)(UC + ((size_t)(g * 1280 + R)) * 256 + t * 16 + c0) = w; *(u32x4*)(A2 + ((size_t)(g * 1280 + R)) * 512 + t * 16 + c0) = w; }
                    else *(u32x4*)(P + (size_t)row * LDP + (colbase - 512) + bj * HALF) = w;
                }
            }
    }
};
struct EpiS5E {
    static constexpr bool PERM = true;
    float* E;
    __device__ __forceinline__ void operator()(const f32x4 (&acc)[2][2][4][2], const Unit& u, int wr, int wc, int fr, int fq) const {
#pragma unroll
        for (int ai = 0; ai < 2; ++ai)
#pragma unroll
            for (int m = 0; m < 4; ++m) { float* ep = E + (size_t)(u.pm * BM + ai * HALF + wr * 64 + m * 16 + fr) * 256 + wc * 32 + 8 * fq;
#pragma unroll
                for (int bj = 0; bj < 2; ++bj) { *(f32x4*)(ep + bj * HALF) = acc[ai][bj][m][0]; *(f32x4*)(ep + bj * HALF + 4) = acc[ai][bj][m][1]; } }
    }
};
__device__ __forceinline__ float gelu_tanh_e(float x) { const float u = 0.7978845608028654f * (x + 0.044715f * x * x * x); const float e = __expf(2.f * u); return x * (1.f - __builtin_amdgcn_rcpf(e + 1.f)); }
struct EpiS5Y {
    static constexpr bool PERM = true;
    bf16_t* YG;
    __device__ __forceinline__ void operator()(const f32x4 (&acc)[2][2][4][2], const Unit& u, int wr, int wc, int fr, int fq) const {
        const int g = u.pn, panel = u.pm - 5 * g;
#pragma unroll
        for (int ai = 0; ai < 2; ++ai)
#pragma unroll
            for (int m = 0; m < 4; ++m) { const int Rl = panel * BM + ai * HALF + wr * 64 + m * 16 + fr;
                const bool ok = (panel != 0) || (Rl < 16); const int n0 = panel == 0 ? 16 * Rl : 16 * (Rl - 240);
#pragma unroll
                for (int bj = 0; bj < 2; ++bj) { const int t = 8 * bj + 2 * wc + (fq >> 1), c0 = 8 * (fq & 1);
                    const f32x4 v0 = acc[ai][bj][m][0], v1 = acc[ai][bj][m][1];
                    u32x4 w; w.x = cvt_pk_bf16(gelu_tanh_e(v0[0]), gelu_tanh_e(v0[1])); w.y = cvt_pk_bf16(gelu_tanh_e(v0[2]), gelu_tanh_e(v0[3]));
                    w.z = cvt_pk_bf16(gelu_tanh_e(v1[0]), gelu_tanh_e(v1[1])); w.w = cvt_pk_bf16(gelu_tanh_e(v1[2]), gelu_tanh_e(v1[3]));
                    if (ok) *(u32x4*)(YG + (size_t)(n0 + t) * 512 + g * 16 + c0) = w; } }
    }
};
struct EpiGlu {
    static constexpr bool PERM = true;
    const bf16_t* YG; bf16_t* MIXp;
    __device__ __forceinline__ void operator()(const f32x4 (&acc)[2][2][4][2], const Unit& u, int wr, int wc, int fr, int fq) const {
        const int colbase = u.pn * BM + wc * 32 + 8 * fq;
#pragma unroll
        for (int ai = 0; ai < 2; ++ai)
#pragma unroll
            for (int m = 0; m < 4; ++m) { const int row = u.pm * BM + ai * HALF + wr * 64 + m * 16 + fr;
#pragma unroll
                for (int bj = 0; bj < 2; ++bj) { const u32x4 y = *(const u32x4*)(YG + (size_t)row * 512 + colbase + bj * HALF);
                    const f32x4 v0 = acc[ai][bj][m][0], v1 = acc[ai][bj][m][1];
                    float r[8];
#pragma unroll
                    for (int e = 0; e < 4; ++e) { r[e] = __builtin_amdgcn_rcpf(1.f + __expf(-v0[e])); r[4 + e] = __builtin_amdgcn_rcpf(1.f + __expf(-v1[e])); }
                    u32x4 w;
                    w.x = cvt_pk_bf16(__uint_as_float(y.x << 16) * r[0], __uint_as_float(y.x & 0xffff0000u) * r[1]); w.y = cvt_pk_bf16(__uint_as_float(y.y << 16) * r[2], __uint_as_float(y.y & 0xffff0000u) * r[3]);
                    w.z = cvt_pk_bf16(__uint_as_float(y.z << 16) * r[4], __uint_as_float(y.z & 0xffff0000u) * r[5]); w.w = cvt_pk_bf16(__uint_as_float(y.w << 16) * r[6], __uint_as_float(y.w & 0xffff0000u) * r[7]);
                    *(u32x4*)(MIXp + (size_t)row * DM + colbase + bj * HALF) = w; } }
    }
};
}

namespace da {
constexpr int NW = 8, QBLK = 32, KVBLK = 64;
constexpr int SHM_V = KVBLK * 128 * 2, SHM_K = KVBLK * 64 * 2;
constexpr int OFF_V = 0, OFF_K = 2 * SHM_V, OFF_WS = OFF_K + 2 * SHM_K, SHM_TOTAL = OFF_WS + NW * 64 * 4;
constexpr float THRL = 8.f * LOG2E;
#define KSWZ64(row, colB) ((row) * 128 + ((colB) ^ ((((row) >> 1) & 7) << 4)))
#define SBAR() __builtin_amdgcn_sched_barrier(0)
__device__ __forceinline__ int crow(int r, int hi) { return (r & 3) + 8 * (r >> 2) + 4 * hi; }
__device__ __forceinline__ unsigned cvtpk(float lo, float hi) { unsigned r; asm volatile("v_cvt_pk_bf16_f32 %0, %1, %2" : "=v"(r) : "v"(lo), "v"(hi)); return r; }

__device__ __forceinline__ int v_st(int k, int c) { const int kk = (k & ~0xC) | ((k & 4) << 1) | ((k & 8) >> 1); return ((kk >> 3) * 4 + (c >> 5)) * 512 + ((kk & 7) * 32 + (c & 31)) * 2; }
__device__ __forceinline__ int v_rd_base(int lane) { return ((lane & 3) << 3) | (((lane >> 2) & 3) << 6) | (((lane >> 4) & 1) << 5) | (((lane >> 5) & 1) << 8); }
constexpr int v_rd_off(int d0, int ks, int half) { return d0 * 512 + ks * 4096 + half * 2048; }
template <int OFF> __device__ __forceinline__ s16x4 tr_read(int vb) {
  s16x4 r; asm volatile("ds_read_b64_tr_b16 %0, %1 offset:%2" : "=&v"(r) : "v"(vb), "i"(OFF) : "memory"); return r;
}
struct VFrag { s16x4 l0, h0, l1, h1, l2, h2, l3, h3; };
template <int D0> __device__ __forceinline__ void v_load8(VFrag& f, int vb) {
  f.l0 = tr_read<v_rd_off(D0, 0, 0)>(vb); f.h0 = tr_read<v_rd_off(D0, 0, 1)>(vb); f.l1 = tr_read<v_rd_off(D0, 1, 0)>(vb); f.h1 = tr_read<v_rd_off(D0, 1, 1)>(vb);
  f.l2 = tr_read<v_rd_off(D0, 2, 0)>(vb); f.h2 = tr_read<v_rd_off(D0, 2, 1)>(vb); f.l3 = tr_read<v_rd_off(D0, 3, 0)>(vb); f.h3 = tr_read<v_rd_off(D0, 3, 1)>(vb);
}
#define PVK(L, H) (bf16x8){L[0], L[1], L[2], L[3], H[0], H[1], H[2], H[3]}
__device__ __forceinline__ void v_mma4(f32x16& od, const VFrag& f, bf16x8 pa0, bf16x8 pa1, bf16x8 pa2, bf16x8 pa3) {
  od = __builtin_amdgcn_mfma_f32_32x32x16_bf16(pa0, PVK(f.l0, f.h0), od, 0, 0, 0);
  od = __builtin_amdgcn_mfma_f32_32x32x16_bf16(pa1, PVK(f.l1, f.h1), od, 0, 0, 0);
  od = __builtin_amdgcn_mfma_f32_32x32x16_bf16(pa2, PVK(f.l2, f.h2), od, 0, 0, 0);
  od = __builtin_amdgcn_mfma_f32_32x32x16_bf16(pa3, PVK(f.l3, f.h3), od, 0, 0, 0);
}
__device__ __forceinline__ void pv_d0(f32x16* o, int vb, bf16x8 pa0, bf16x8 pa1, bf16x8 pa2, bf16x8 pa3) {
  VFrag fa, fb;
  v_load8<0>(fa, vb); v_load8<1>(fb, vb);
  asm volatile("s_waitcnt lgkmcnt(8)" ::: "memory"); SBAR();
  v_mma4(o[0], fa, pa0, pa1, pa2, pa3); SBAR();
  v_load8<2>(fa, vb);
  asm volatile("s_waitcnt lgkmcnt(8)" ::: "memory"); SBAR();
  v_mma4(o[1], fb, pa0, pa1, pa2, pa3); SBAR();
  v_load8<3>(fb, vb);
  asm volatile("s_waitcnt lgkmcnt(8)" ::: "memory"); SBAR();
  v_mma4(o[2], fa, pa0, pa1, pa2, pa3);
  asm volatile("s_waitcnt lgkmcnt(0)" ::: "memory"); SBAR();
  v_mma4(o[3], fb, pa0, pa1, pa2, pa3);
}

#define EX4(B_) do { px[(B_)] = __builtin_amdgcn_exp2f(px[(B_)]); px[(B_) + 1] = __builtin_amdgcn_exp2f(px[(B_) + 1]); px[(B_) + 2] = __builtin_amdgcn_exp2f(px[(B_) + 2]); px[(B_) + 3] = __builtin_amdgcn_exp2f(px[(B_) + 3]); } while (0)
#define EY4(B_) do { py[(B_)] = __builtin_amdgcn_exp2f(py[(B_)]); py[(B_) + 1] = __builtin_amdgcn_exp2f(py[(B_) + 1]); py[(B_) + 2] = __builtin_amdgcn_exp2f(py[(B_) + 2]); py[(B_) + 3] = __builtin_amdgcn_exp2f(py[(B_) + 3]); } while (0)
__device__ __forceinline__ void pv_d0e(f32x16* o, int vb, bf16x8 pa0, bf16x8 pa1, bf16x8 pa2, bf16x8 pa3, f32x16& px, f32x16& py) {
  VFrag fa, fb;
  v_load8<0>(fa, vb); v_load8<1>(fb, vb);
  asm volatile("s_waitcnt lgkmcnt(8)" ::: "memory"); SBAR();
  v_mma4(o[0], fa, pa0, pa1, pa2, pa3); EX4(0); EY4(0); SBAR();
  v_load8<2>(fa, vb);
  asm volatile("s_waitcnt lgkmcnt(8)" ::: "memory"); SBAR();
  v_mma4(o[1], fb, pa0, pa1, pa2, pa3); EX4(4); EY4(4); SBAR();
  v_load8<3>(fb, vb);
  asm volatile("s_waitcnt lgkmcnt(8)" ::: "memory"); SBAR();
  v_mma4(o[2], fa, pa0, pa1, pa2, pa3); EX4(8); EY4(8);
  asm volatile("s_waitcnt lgkmcnt(0)" ::: "memory"); SBAR();
  v_mma4(o[3], fb, pa0, pa1, pa2, pa3); EX4(12); EY4(12);
}
#undef EY4
#undef EX4
typedef __bf16 bf16x2_t __attribute__((ext_vector_type(2)));
__device__ __forceinline__ float dot2sq(unsigned w, float c) { const bf16x2_t v = __builtin_bit_cast(bf16x2_t, w); return __builtin_amdgcn_fdot2_f32_bf16(v, v, c, false); }
__device__ __forceinline__ void expA(f32x16& p0) {
#pragma unroll
  for (int r = 0; r < 16; ++r) p0[r] = __builtin_amdgcn_exp2f(p0[r]);
}
__device__ __forceinline__ unsigned cvtpk_b(float lo, float hi) { const f32x2 v = {lo, hi}; const bf16x2_t b = __builtin_convertvector(v, bf16x2_t); return __builtin_bit_cast(unsigned, b); }
__device__ __forceinline__ void finishB(f32x16& p0, f32x16& p1, float& l_reg, bf16x8& pa0, bf16x8& pa1, bf16x8& pa2, bf16x8& pa3) {
  float ps = 0;
#pragma unroll
  for (int r = 0; r < 16; ++r) ps += p0[r];
#pragma unroll
  for (int r = 0; r < 16; ++r) ps += p1[r];
  { auto rr = __builtin_amdgcn_permlane32_swap(__float_as_uint(ps), __float_as_uint(ps), false, false);
    ps = __uint_as_float(rr[0]) + __uint_as_float(rr[1]); }
  l_reg += ps;
#define PK4(P, BASE, OUT) do { unsigned a0 = cvtpk_b(P[BASE + 0], P[BASE + 1]), a1 = cvtpk_b(P[BASE + 2], P[BASE + 3]);   \
    unsigned b0 = cvtpk_b(P[BASE + 4], P[BASE + 5]), b1 = cvtpk_b(P[BASE + 6], P[BASE + 7]);                              \
    auto r0 = __builtin_amdgcn_permlane32_swap(a0, b0, false, false); auto r1 = __builtin_amdgcn_permlane32_swap(a1, b1, false, false); \
    u32x4 w = {r0[0], r1[0], r0[1], r1[1]}; OUT = *reinterpret_cast<bf16x8*>(&w); } while (0)
  PK4(p0, 0, pa0); PK4(p0, 8, pa1); PK4(p1, 0, pa2); PK4(p1, 8, pa3);
#undef PK4
}
__device__ __forceinline__ void k_pre(bf16x8 (&kf)[8], const char* Ks, int r32, int hi) {
#pragma unroll
  for (int d0 = 0; d0 < 4; ++d0) { const int cb = (d0 * 16 + hi * 8) * 2;
    kf[2 * d0] = *reinterpret_cast<const bf16x8*>(Ks + KSWZ64(r32, cb)); kf[2 * d0 + 1] = *reinterpret_cast<const bf16x8*>(Ks + KSWZ64(32 + r32, cb)); }
}
__device__ __forceinline__ void qkt_k(f32x16& p0, f32x16& p1, const f32x16& pinit, const bf16x8 (&kf)[8], const bf16x8* qr) {
  p0 = pinit; p1 = pinit;
#pragma unroll
  for (int d0 = 0; d0 < 4; ++d0) { p0 = __builtin_amdgcn_mfma_f32_32x32x16_bf16(kf[2 * d0], qr[d0], p0, 0, 0, 0); p1 = __builtin_amdgcn_mfma_f32_32x32x16_bf16(kf[2 * d0 + 1], qr[d0], p1, 0, 0, 0); }
}
__device__ __forceinline__ void qkt_i(f32x16& p0, f32x16& p1, const f32x16& pinit, const char* Ks, const bf16x8* qr, int r32, int hi) {
  p0 = pinit; p1 = pinit;
#pragma unroll
  for (int d0 = 0; d0 < 4; ++d0) { const int cb = (d0 * 16 + hi * 8) * 2;
    bf16x8 b0 = *reinterpret_cast<const bf16x8*>(Ks + KSWZ64(r32, cb));
    bf16x8 b1 = *reinterpret_cast<const bf16x8*>(Ks + KSWZ64(32 + r32, cb));
    p0 = __builtin_amdgcn_mfma_f32_32x32x16_bf16(b0, qr[d0], p0, 0, 0, 0);
    p1 = __builtin_amdgcn_mfma_f32_32x32x16_bf16(b1, qr[d0], p1, 0, 0, 0); }
}
__device__ __forceinline__ void attn_comp(const bf16_t* __restrict__ Qb, const bf16_t* __restrict__ Kh, const bf16_t* __restrict__ Vh, int seq, float kmx, char* lds, f32x16 (&o)[4], const int wv) {
  const int tid = wv * 64 + lane_now();
  const int wid = tid >> 6, lane = tid & 63, r32 = lane & 31, hi = lane >> 5;
  char* V_lds = lds + OFF_V; char* K_lds = lds + OFF_K;
  float* wsb = (float*)(lds + OFF_WS); float* li_l = wsb + wid * 64;
  float l_reg = 0; bf16x8 qr[4];
#pragma unroll
  for (int d = 0; d < 4; ++d) o[d] = f32x16{};
  const bf16_t* Qw = Qb + (long)(wid * QBLK + r32) * LDP + hi * 8;
#pragma unroll
  for (int d0 = 0; d0 < 4; ++d0) qr[d0] = *reinterpret_cast<const bf16x8*>(Qw + d0 * 16);
  float qsq = 0.f;
#pragma unroll
  for (int d0 = 0; d0 < 4; ++d0) { const u32x4 w = *reinterpret_cast<const u32x4*>(&qr[d0]); qsq = dot2sq(w.x, qsq); qsq = dot2sq(w.y, qsq); qsq = dot2sq(w.z, qsq); qsq = dot2sq(w.w, qsq); }
  { auto rr = __builtin_amdgcn_permlane32_swap(__float_as_uint(qsq), __float_as_uint(qsq), false, false); qsq = __uint_as_float(rr[0]) + __uint_as_float(rr[1]); }
  const int sr = tid >> 4, sc = (tid & 15) * 8, vst0 = v_st(sr, sc), vst1 = v_st(32 + sr, sc);
  const int kr = tid >> 3, kc = (tid & 7) * 8, kst = KSWZ64(kr, kc * 2);
  const int vb0 = (int)(uintptr_t)V_lds + v_rd_base(lane);
  struct { bf16x8 vs0, vs1, ks0; } sr_[1];
#define SLOAD(i, k0) do { sr_[i].ks0 = *reinterpret_cast<const bf16x8*>(&Kh[(long)((k0) + kr) * LDP + kc]); \
    sr_[i].vs0 = *reinterpret_cast<const bf16x8*>(&Vh[(long)((k0) + sr) * LDP + sc]); sr_[i].vs1 = *reinterpret_cast<const bf16x8*>(&Vh[(long)((k0) + 32 + sr) * LDP + sc]); } while (0)
#define SWRITEK(b, i) do { *(bf16x8*)(K_lds + (b) * SHM_K + kst) = sr_[i].ks0; } while (0)
#define SWRITEV(b, i) do { *(bf16x8*)(V_lds + (b) * SHM_V + vst0) = sr_[i].vs0; *(bf16x8*)(V_lds + (b) * SHM_V + vst1) = sr_[i].vs1; } while (0)
#define SWRITE(b, i) do { SWRITEK(b, i); SWRITEV(b, i); } while (0)
#define SWAIT() asm volatile("s_waitcnt vmcnt(0)" ::: "memory")
#define SWAITK() asm volatile("s_waitcnt vmcnt(2)" ::: "memory")
  f32x16 pA0, pA1, pB0, pB1; bf16x8 pa0, pa1, pa2, pa3; const int NTL = seq / KVBLK;
  SLOAD(0, 0); asm volatile("s_waitcnt vmcnt(0)" ::: "memory"); SWRITE(0, 0); __syncthreads();
  const float mrow = sqrtf(qsq * kmx) * 1.01f;
  f32x16 pinit;
#pragma unroll
  for (int r = 0; r < 16; ++r) pinit[r] = -mrow;
  SLOAD(0, KVBLK);
  qkt_i(pA0, pA1, pinit, K_lds, qr, r32, hi); expA(pA0); expA(pA1);
  SWAIT(); SWRITE(1, 0); __syncthreads();
  for (int j = 1; j + 1 < NTL; j += 2) {
    SLOAD(0, (j + 1) * KVBLK);
    { bf16x8 kf[8]; SBAR(); k_pre(kf, K_lds + SHM_K, r32, hi); SBAR(); qkt_k(pB0, pB1, pinit, kf, qr);
    finishB(pA0, pA1, l_reg, pa0, pa1, pa2, pa3); SBAR(); }
    SWAITK(); SWRITEK(0, 0); SBAR();
    pv_d0e(o, vb0, pa0, pa1, pa2, pa3, pB0, pB1);
    __syncthreads(); SWAIT(); SWRITEV(0, 0);
    SLOAD(0, (j + 2) * KVBLK);
    { bf16x8 kf[8]; SBAR(); k_pre(kf, K_lds, r32, hi); SBAR(); qkt_k(pA0, pA1, pinit, kf, qr);
    finishB(pB0, pB1, l_reg, pa0, pa1, pa2, pa3); SBAR(); }
    SWAITK(); SWRITEK(1, 0); SBAR();
    pv_d0e(o, vb0 + SHM_V, pa0, pa1, pa2, pa3, pA0, pA1);
    __syncthreads(); SWAIT(); SWRITEV(1, 0);
  }
  SBAR(); qkt_i(pB0, pB1, pinit, K_lds + SHM_K, qr, r32, hi);
  finishB(pA0, pA1, l_reg, pa0, pa1, pa2, pa3); SBAR();
  pv_d0e(o, vb0, pa0, pa1, pa2, pa3, pB0, pB1);
  __syncthreads();
  finishB(pB0, pB1, l_reg, pa0, pa1, pa2, pa3); SBAR();
  pv_d0(o, vb0 + SHM_V, pa0, pa1, pa2, pa3);
  if (hi == 0) li_l[r32] = l_reg; asm volatile("s_waitcnt lgkmcnt(0)" ::: "memory");
#pragma unroll
  for (int r = 0; r < 16; ++r) { const float rl = __builtin_amdgcn_rcpf(li_l[crow(r, hi)]);
#pragma unroll
    for (int d0 = 0; d0 < 4; ++d0) o[d0][r] *= rl; }
  __syncthreads();
#undef SLOAD
#undef SWRITE
#undef SWRITEK
#undef SWRITEV
#undef SWAITK
#undef SWAIT
}

__device__ __forceinline__ void diff_unit(const bf16_t* __restrict__ PROJ, int h, int row0, int seq, float kmx0, float kmx1, float lam, float omli, const float* __restrict__ subln,
                                          float* __restrict__ O1, bf16_t* __restrict__ MIX, char* lds, const int wv) {
  const int tid = wv * 64 + lane_now();
  const int wid = tid >> 6, lane = tid & 63, r32 = lane & 31, hi = lane >> 5;
  f32x16 o[4];
  attn_comp(PROJ + (size_t)row0 * LDP + h * 128, PROJ + 1024 + h * 128, PROJ + 2048 + h * 128, seq, kmx0, lds, o, wv);
  float* O1w = O1 + (size_t)(row0 + wid * QBLK) * 1024 + h * 128 + r32;
#pragma unroll
  for (int r = 0; r < 16; ++r) { const int orow = crow(r, hi);
#pragma unroll
    for (int d0 = 0; d0 < 4; ++d0) O1w[(size_t)orow * 1024 + d0 * 32] = o[d0][r]; }
  attn_comp(PROJ + (size_t)row0 * LDP + h * 128 + 64, PROJ + 1024 + h * 128 + 64, PROJ + 2048 + h * 128, seq, kmx1, lds, o, wv);
  float sw[4];
#pragma unroll
  for (int d0 = 0; d0 < 4; ++d0) sw[d0] = subln[d0 * 32 + r32] * omli;
  bf16_t* Mw = MIX + (size_t)(row0 + wid * QBLK) * DM + h * 128 + r32;
#pragma unroll
  for (int r = 0; r < 16; ++r) { const int orow = crow(r, hi);
    float v[4]; float ss = 0.f;
#pragma unroll
    for (int d0 = 0; d0 < 4; ++d0) { v[d0] = O1w[(size_t)orow * 1024 + d0 * 32] - lam * o[d0][r]; ss += v[d0] * v[d0]; }
    ss = half_sum32(ss);
    const float rs = rsqrtf(ss * (1.f / 128.f) + EPS);
#pragma unroll
    for (int d0 = 0; d0 < 4; ++d0) { const unsigned pk = cvtpk(v[d0] * rs * sw[d0], 0.f); Mw[(size_t)orow * DM + d0 * 32] = (bf16_t)(pk & 0xffffu); }
  }
}
}


namespace rt {
using da::crow; using da::cvtpk; using da::v_st; using da::v_rd_base; using da::pv_d0;
#define KSWZ128(row, colB) ((row) * 256 + ((colB) ^ (((row) & 7) << 4)))
constexpr int NCH = 65;
__device__ __forceinline__ s16x4 tr_read_a(int addr) { s16x4 r; asm volatile("ds_read_b64_tr_b16 %0, %1" : "=&v"(r) : "v"(addr) : "memory"); return r; }
#define RT_PK(L, H) (bf16x8){L[0], L[1], L[2], L[3], H[0], H[1], H[2], H[3]}
__device__ __forceinline__ void kv_unit(const bf16_t* __restrict__ PROJ, int h, int k, float lg2f, float lg2r, h16* __restrict__ KV, char* lds, const int wv) {
  const int tid = wv * 64 + lane_now();
  const int wid = tid >> 6, lane = tid & 63, r32 = lane & 31, hi = lane >> 5;
  const int row0 = 256 * k;
  {
    bf16x8 rg[16];
#pragma unroll
    for (int half = 0; half < 2; ++half)
#pragma unroll
      for (int i = 0; i < 8; ++i) { const int p = tid + 512 * i, tok = p >> 4, c8 = (p & 15) * 8;
        rg[half * 8 + i] = *reinterpret_cast<const bf16x8*>(PROJ + (size_t)(row0 + tok) * LDP + (half ? 3072 : 1536) + h * 128 + c8); }
#pragma unroll
    for (int half = 0; half < 2; ++half)
#pragma unroll
      for (int i = 0; i < 8; ++i) { const int p = tid + 512 * i, tok = p >> 4, c8 = (p & 15) * 8;
        *(bf16x8*)(lds + half * 65536 + (tok >> 6) * 16384 + v_st(tok & 63, c8)) = rg[half * 8 + i]; }
  }
  __syncthreads();
  const int dir = wid >> 2, D0a = wid & 3;
  const float lg2 = dir ? lg2r : lg2f;
  f32x16 acc[4];
#pragma unroll
  for (int d = 0; d < 4; ++d) acc[d] = f32x16{};
  const int kb = (int)(uintptr_t)lds + v_rd_base(lane) + D0a * 512, vb = (int)(uintptr_t)lds + 65536 + v_rd_base(lane);
#pragma unroll
  for (int t = 0; t < 4; ++t)
#pragma unroll
    for (int ks = 0; ks < 4; ++ks) {
      const s16x4 kl = tr_read_a(kb + t * 16384 + ks * 4096), kh = tr_read_a(kb + t * 16384 + ks * 4096 + 2048);
      s16x4 vl[4], vh[4];
#pragma unroll
      for (int d0 = 0; d0 < 4; ++d0) { vl[d0] = tr_read_a(vb + t * 16384 + ks * 4096 + d0 * 512); vh[d0] = tr_read_a(vb + t * 16384 + ks * 4096 + d0 * 512 + 2048); }
      asm volatile("s_waitcnt lgkmcnt(0)" ::: "memory"); __builtin_amdgcn_sched_barrier(0);
      const int tok0 = 64 * t + 16 * ks + 8 * hi;
      float w[8];
#pragma unroll
      for (int j = 0; j < 8; ++j) { const int e = dir ? (tok0 + j) : (255 - tok0 - j); w[j] = __builtin_amdgcn_exp2f(lg2 * (float)e); }
      u32x4 aw;
      aw.x = cvtpk(bf2f((unsigned short)kl[0]) * w[0], bf2f((unsigned short)kl[1]) * w[1]); aw.y = cvtpk(bf2f((unsigned short)kl[2]) * w[2], bf2f((unsigned short)kl[3]) * w[3]);
      aw.z = cvtpk(bf2f((unsigned short)kh[0]) * w[4], bf2f((unsigned short)kh[1]) * w[5]); aw.w = cvtpk(bf2f((unsigned short)kh[2]) * w[6], bf2f((unsigned short)kh[3]) * w[7]);
      const bf16x8 af = *reinterpret_cast<bf16x8*>(&aw);
#pragma unroll
      for (int d0 = 0; d0 < 4; ++d0) acc[d0] = __builtin_amdgcn_mfma_f32_32x32x16_bf16(af, RT_PK(vl[d0], vh[d0]), acc[d0], 0, 0, 0);
    }
  h16* out = KV + ((size_t)(dir * 12 + h) * NCH + k) * 16384 + (size_t)(32 * D0a) * 128 + r32;
#pragma unroll
  for (int r = 0; r < 16; ++r)
#pragma unroll
    for (int d0 = 0; d0 < 4; ++d0) out[(size_t)crow(r, hi) * 128 + d0 * 32] = (h16)acc[d0][r];
  __syncthreads();
}
__device__ __forceinline__ void qkt128(f32x16& p0, f32x16& p1, const char* Ks, const bf16x8* qr, int r32, int hi) {
  p0 = f32x16{}; p1 = f32x16{};
#pragma unroll
  for (int d0 = 0; d0 < 8; ++d0) { const int cb = (d0 * 16 + hi * 8) * 2;
    bf16x8 b0 = *reinterpret_cast<const bf16x8*>(Ks + KSWZ128(r32, cb));
    bf16x8 b1 = *reinterpret_cast<const bf16x8*>(Ks + KSWZ128(32 + r32, cb));
    p0 = __builtin_amdgcn_mfma_f32_32x32x16_bf16(b0, qr[d0], p0, 0, 0, 0);
    p1 = __builtin_amdgcn_mfma_f32_32x32x16_bf16(b1, qr[d0], p1, 0, 0, 0); }
}
__device__ __forceinline__ void p_to_frag(const f32x16& p0, const f32x16& p1, bf16x8& pa0, bf16x8& pa1, bf16x8& pa2, bf16x8& pa3) {
#define PK4(P, BASE, OUT) do { unsigned a0 = cvtpk(P[BASE + 0], P[BASE + 1]), a1 = cvtpk(P[BASE + 2], P[BASE + 3]);   \
    unsigned b0 = cvtpk(P[BASE + 4], P[BASE + 5]), b1 = cvtpk(P[BASE + 6], P[BASE + 7]);                              \
    auto r0 = __builtin_amdgcn_permlane32_swap(a0, b0, false, false); auto r1 = __builtin_amdgcn_permlane32_swap(a1, b1, false, false); \
    u32x4 w = {r0[0], r1[0], r0[1], r1[1]}; OUT = *reinterpret_cast<bf16x8*>(&w); } while (0)
  PK4(p0, 0, pa0); PK4(p0, 8, pa1); PK4(p1, 0, pa2); PK4(p1, 8, pa3);
#undef PK4
}
__device__ __forceinline__ void ret_tile(f32x16 (&o)[4], const char* Kt, int vb, const bf16x8* qr, int t, int wid, int r32, int hi, float lg2f, float lg2r) {
  f32x16 p0, p1;
  qkt128(p0, p1, Kt, qr, r32, hi);
  const int i = wid * 32 + r32;
#pragma unroll
  for (int r = 0; r < 16; ++r) {
    const int j0 = 64 * t + crow(r, hi), d0_ = i - j0, d1_ = d0_ - 32;
    const float w0 = d0_ > 0 ? __builtin_amdgcn_exp2f(lg2f * (float)d0_) : (d0_ < 0 ? __builtin_amdgcn_exp2f(lg2r * (float)(-d0_)) : 2.f);
    const float w1 = d1_ > 0 ? __builtin_amdgcn_exp2f(lg2f * (float)d1_) : (d1_ < 0 ? __builtin_amdgcn_exp2f(lg2r * (float)(-d1_)) : 2.f);
    p0[r] *= w0; p1[r] *= w1; }
  bf16x8 pa0, pa1, pa2, pa3;
  p_to_frag(p0, p1, pa0, pa1, pa2, pa3);
  pv_d0(o, vb, pa0, pa1, pa2, pa3);
}
__device__ __forceinline__ void out_unit(const bf16_t* __restrict__ PROJ, int h, int k, float lg2f, float lg2r, const bf16_t* __restrict__ SIN, bf16_t* __restrict__ MIX, char* lds, const int wv) {
  const int tid = wv * 64 + lane_now();
  const int wid = tid >> 6, lane = tid & 63, r32 = lane & 31, hi = lane >> 5;
  const int row0 = 256 * k;
  const int sr = tid >> 4, sc8 = (tid & 15) * 8;
  const bf16_t* Kg = PROJ + (size_t)row0 * LDP + 1536 + h * 128 + sc8; const bf16_t* Vg = PROJ + (size_t)row0 * LDP + 3072 + h * 128 + sc8;
  bf16x8 rs[8], rk[8];
  if (k > 0) {
#pragma unroll
    for (int dir = 0; dir < 2; ++dir) { const bf16_t* Sg = SIN + ((size_t)(dir * 12 + h) * NCH + k) * 16384;
#pragma unroll
      for (int i = 0; i < 4; ++i) { const int p = tid + 512 * i; rs[dir * 4 + i] = *reinterpret_cast<const bf16x8*>(Sg + (size_t)(p >> 4) * 128 + (p & 15) * 8); } }
  }
#pragma unroll
  for (int t = 0; t < 2; ++t) { rk[t * 4 + 0] = *reinterpret_cast<const bf16x8*>(Kg + (size_t)(64 * t + sr) * LDP); rk[t * 4 + 1] = *reinterpret_cast<const bf16x8*>(Kg + (size_t)(64 * t + 32 + sr) * LDP);
    rk[t * 4 + 2] = *reinterpret_cast<const bf16x8*>(Vg + (size_t)(64 * t + sr) * LDP); rk[t * 4 + 3] = *reinterpret_cast<const bf16x8*>(Vg + (size_t)(64 * t + 32 + sr) * LDP); }
  bf16x8 qr[8];
  { const bf16_t* Qw = PROJ + (size_t)(row0 + wid * 32 + r32) * LDP + h * 128 + hi * 8;
#pragma unroll
    for (int d0 = 0; d0 < 8; ++d0) qr[d0] = *reinterpret_cast<const bf16x8*>(Qw + d0 * 16); }
  if (k > 0) {
#pragma unroll
    for (int dir = 0; dir < 2; ++dir)
#pragma unroll
      for (int i = 0; i < 4; ++i) { const int p = tid + 512 * i, srow = p >> 4, c8 = (p & 15) * 8; *(bf16x8*)(lds + dir * 32768 + (srow >> 6) * 16384 + v_st(srow & 63, c8)) = rs[dir * 4 + i]; }
  }
#pragma unroll
  for (int t = 0; t < 2; ++t) { char* B = lds + 65536 + t * 32768;
    *(bf16x8*)(B + KSWZ128(sr, sc8 * 2)) = rk[t * 4 + 0]; *(bf16x8*)(B + KSWZ128(32 + sr, sc8 * 2)) = rk[t * 4 + 1];
    *(bf16x8*)(B + 16384 + v_st(sr, sc8)) = rk[t * 4 + 2]; *(bf16x8*)(B + 16384 + v_st(32 + sr, sc8)) = rk[t * 4 + 3]; }
  __syncthreads();
#pragma unroll
  for (int t = 0; t < 2; ++t) { rk[t * 4 + 0] = *reinterpret_cast<const bf16x8*>(Kg + (size_t)(128 + 64 * t + sr) * LDP); rk[t * 4 + 1] = *reinterpret_cast<const bf16x8*>(Kg + (size_t)(128 + 64 * t + 32 + sr) * LDP);
    rk[t * 4 + 2] = *reinterpret_cast<const bf16x8*>(Vg + (size_t)(128 + 64 * t + sr) * LDP); rk[t * 4 + 3] = *reinterpret_cast<const bf16x8*>(Vg + (size_t)(128 + 64 * t + 32 + sr) * LDP); }
  f32x16 o[4];
#pragma unroll
  for (int d = 0; d < 4; ++d) o[d] = f32x16{};
  const int vb0 = (int)(uintptr_t)lds + v_rd_base(lane);
  if (k > 0) {
#pragma unroll 1
    for (int dir = 0; dir < 2; ++dir) {
      const float lg2 = dir ? lg2r : lg2f; const int i = wid * 32 + r32;
      const float sc = __builtin_amdgcn_exp2f(lg2 * (float)(dir ? (256 - i) : (i + 1)));
      bf16x8 qs[8];
#pragma unroll
      for (int d0 = 0; d0 < 8; ++d0) { const u32x4 w = *reinterpret_cast<const u32x4*>(&qr[d0]); u32x4 z;
        z.x = cvtpk(__uint_as_float(w.x << 16) * sc, __uint_as_float(w.x & 0xffff0000u) * sc); z.y = cvtpk(__uint_as_float(w.y << 16) * sc, __uint_as_float(w.y & 0xffff0000u) * sc);
        z.z = cvtpk(__uint_as_float(w.z << 16) * sc, __uint_as_float(w.z & 0xffff0000u) * sc); z.w = cvtpk(__uint_as_float(w.w << 16) * sc, __uint_as_float(w.w & 0xffff0000u) * sc);
        qs[d0] = *reinterpret_cast<bf16x8*>(&z); }
      pv_d0(o, vb0 + dir * 32768, qs[0], qs[1], qs[2], qs[3]);
      pv_d0(o, vb0 + dir * 32768 + 16384, qs[4], qs[5], qs[6], qs[7]);
    }
  }
  __syncthreads();
#pragma unroll
  for (int t = 0; t < 2; ++t) { char* B = lds + t * 32768;
    *(bf16x8*)(B + KSWZ128(sr, sc8 * 2)) = rk[t * 4 + 0]; *(bf16x8*)(B + KSWZ128(32 + sr, sc8 * 2)) = rk[t * 4 + 1];
    *(bf16x8*)(B + 16384 + v_st(sr, sc8)) = rk[t * 4 + 2]; *(bf16x8*)(B + 16384 + v_st(32 + sr, sc8)) = rk[t * 4 + 3]; }
  ret_tile(o, lds + 65536, vb0 + 65536 + 16384, qr, 0, wid, r32, hi, lg2f, lg2r);
  ret_tile(o, lds + 98304, vb0 + 98304 + 16384, qr, 1, wid, r32, hi, lg2f, lg2r);
  __syncthreads();
  ret_tile(o, lds, vb0 + 16384, qr, 2, wid, r32, hi, lg2f, lg2r);
  ret_tile(o, lds + 32768, vb0 + 32768 + 16384, qr, 3, wid, r32, hi, lg2f, lg2r);
  char* Wt = lds + 65536 + wid * 8192;
  u32x4 gv[8];
#pragma unroll
  for (int i = 0; i < 8; ++i) { const int id = lane + 64 * i; gv[i] = *(const u32x4*)(PROJ + (size_t)(row0 + wid * 32 + (id >> 4)) * LDP + 4608 + h * 128 + (id & 15) * 8); }
#pragma unroll
  for (int r = 0; r < 16; ++r) { const int orow = crow(r, hi);
    float ss = 0.f;
#pragma unroll
    for (int d0 = 0; d0 < 4; ++d0) ss += o[d0][r] * o[d0][r];
    ss = half_sum32(ss);
    const float rs_ = rsqrtf(ss * (1.f / 128.f) + EPS);
#pragma unroll
    for (int d0 = 0; d0 < 4; ++d0) { const unsigned pk = cvtpk(o[d0][r] * rs_, 0.f); *(bf16_t*)(Wt + orow * 256 + (d0 * 32 + r32) * 2) = (bf16_t)(pk & 0xffffu); } }
  asm volatile("s_waitcnt lgkmcnt(0)" ::: "memory"); __builtin_amdgcn_wave_barrier();
#pragma unroll
  for (int i = 0; i < 8; ++i) { const int id = lane + 64 * i, row = id >> 4, c8 = (id & 15) * 8;
    const u32x4 y = *(const u32x4*)(Wt + row * 256 + c8 * 2);
    const size_t grow = (size_t)(row0 + wid * 32 + row);
    const u32x4 g = gv[i];
    u32x4 w;
#define SILUQ(x_) ((x_) * __builtin_amdgcn_rcpf(1.f + __expf(-(x_))))
#define GATE2(Y, G) cvtpk(__uint_as_float((Y) << 16) * SILUQ(__uint_as_float((G) << 16)), __uint_as_float((Y) & 0xffff0000u) * SILUQ(__uint_as_float((G) & 0xffff0000u)))
    w.x = GATE2(y.x, g.x); w.y = GATE2(y.y, g.y); w.z = GATE2(y.z, g.z); w.w = GATE2(y.w, g.w);
#undef GATE2
#undef SILUQ
    *(u32x4*)(MIX + grow * DM + 512 + h * 128 + c8) = w; }
  __syncthreads();
}
__device__ __forceinline__ void na_unit(const bf16_t* __restrict__ PROJ, int h, int qb, const float* __restrict__ rpb_h, bf16_t* __restrict__ MIX, char* lds, const int wv) {
  const int tid = wv * 64 + lane_now();
  const int wid = tid >> 6, lane = tid & 63, r32 = lane & 31, hi = lane >> 5;
  const bool lat = qb >= 0;
  const int row0 = lat ? NCTX + 256 * qb : 0;
  float* wsl = (float*)(lds + 32768) + wid * 64; float* al_l = wsl; float* li_l = wsl + 32;
  float* rpbL = (float*)(lds + 32768 + 2048);
  if (lat && tid < 480) { const int dr = tid >> 5, dc = tid & 31; rpbL[tid] = dc < 31 ? rpb_h[dr * 31 + dc] * LOG2E : 0.f; }
  bf16x8 qr[8];
  { const bf16_t* Qw = PROJ + (size_t)(row0 + wid * 32 + r32) * LDP + 3072 + h * 128 + hi * 8;
#pragma unroll
    for (int d0 = 0; d0 < 8; ++d0) qr[d0] = *reinterpret_cast<const bf16x8*>(Qw + d0 * 16); }
  const int qrow = 4 * qb + (wid >> 1), jq = 32 * (wid & 1) + r32;
  const int r0q = min(max(qrow - 4, 0), 248), c0 = min(max(jq - 8, 0), 48), R0 = min(max(4 * qb - 4, 0), 244);
  const int ntile = lat ? 16 : 4, nloc = lat ? 12 : 0;
  f32x16 o[4];
#pragma unroll
  for (int d = 0; d < 4; ++d) o[d] = f32x16{};
  float m_reg = -1e30f, l_reg = 0.f;
  const int vb0 = (int)(uintptr_t)lds + v_rd_base(lane);
  const int sr = tid >> 4, sc8 = (tid & 15) * 8;
  bf16x8 k0, k1, v0, v1;
#define NA_LOAD(tile_) do { const bool lc_ = (tile_) < nloc; const int krow0_ = lc_ ? NCTX + 64 * (R0 + (tile_)) : 64 * ((tile_) - nloc); \
    const bf16_t* Kg_ = PROJ + (size_t)krow0_ * LDP + 4096 + h * 128; const bf16_t* Vg_ = PROJ + (size_t)krow0_ * LDP + 5120 + h * 128; \
    k0 = *reinterpret_cast<const bf16x8*>(Kg_ + (size_t)sr * LDP + sc8); k1 = *reinterpret_cast<const bf16x8*>(Kg_ + (size_t)(32 + sr) * LDP + sc8); \
    v0 = *reinterpret_cast<const bf16x8*>(Vg_ + (size_t)sr * LDP + sc8); v1 = *reinterpret_cast<const bf16x8*>(Vg_ + (size_t)(32 + sr) * LDP + sc8); } while (0)
#define NA_WRITE(bo_) do { *(bf16x8*)(lds + (bo_) + KSWZ128(sr, sc8 * 2)) = k0; *(bf16x8*)(lds + (bo_) + KSWZ128(32 + sr, sc8 * 2)) = k1; \
    *(bf16x8*)(lds + (bo_) + 16384 + v_st(sr, sc8)) = v0; *(bf16x8*)(lds + (bo_) + 16384 + v_st(32 + sr, sc8)) = v1; } while (0)
  NA_LOAD(0); NA_WRITE(0); if (ntile > 1) NA_LOAD(1);
  __syncthreads();
#pragma unroll 1
  for (int tile = 0; tile < ntile; ++tile) {
    const bool local = tile < nloc; const int kr = R0 + tile;
    const int bo = (tile & 1) * 65536;
    if (tile + 1 < ntile) { NA_WRITE(65536 - bo); if (tile + 2 < ntile) NA_LOAD(tile + 2); }
    const bool active = !local || (kr >= r0q && kr < r0q + 8);
    if (active) {
      f32x16 p0, p1;
      qkt128(p0, p1, lds + bo, qr, r32, hi);
      if (local) {
        const float* bl = rpbL + (kr - qrow + 7) * 32 + 15 - jq;
#pragma unroll
        for (int r = 0; r < 16; ++r) { const int j0 = crow(r, hi), j1 = j0 + 32;
          const bool ok0 = (j0 >= c0) && (j0 < c0 + 16), ok1 = (j1 >= c0) && (j1 < c0 + 16);
          const float b0 = bl[ok0 ? j0 : jq], b1 = bl[ok1 ? j1 : jq];
          p0[r] = ok0 ? p0[r] + b0 : -1e30f; p1[r] = ok1 ? p1[r] + b1 : -1e30f; }
      }
      float pmax = p0[0];
#pragma unroll
      for (int r = 1; r < 16; ++r) pmax = fmaxf(pmax, p0[r]);
#pragma unroll
      for (int r = 0; r < 16; ++r) pmax = fmaxf(pmax, p1[r]);
      { auto rr = __builtin_amdgcn_permlane32_swap(__float_as_uint(pmax), __float_as_uint(pmax), false, false); pmax = fmaxf(__uint_as_float(rr[0]), __uint_as_float(rr[1])); }
      const float mn = fmaxf(m_reg, pmax); const float alpha = __builtin_amdgcn_exp2f(m_reg - mn); m_reg = mn;
      float ps = 0.f;
#pragma unroll
      for (int r = 0; r < 16; ++r) { p0[r] = __builtin_amdgcn_exp2f(p0[r] - mn); p1[r] = __builtin_amdgcn_exp2f(p1[r] - mn); ps += p0[r] + p1[r]; }
      { auto rr = __builtin_amdgcn_permlane32_swap(__float_as_uint(ps), __float_as_uint(ps), false, false); ps = __uint_as_float(rr[0]) + __uint_as_float(rr[1]); }
      l_reg = l_reg * alpha + ps;
      if (hi == 0) al_l[r32] = alpha; asm volatile("s_waitcnt lgkmcnt(0)" ::: "memory");
#pragma unroll
      for (int r = 0; r < 16; ++r) { const float a = al_l[crow(r, hi)];
#pragma unroll
        for (int d = 0; d < 4; ++d) o[d][r] *= a; }
      bf16x8 pa0, pa1, pa2, pa3;
      p_to_frag(p0, p1, pa0, pa1, pa2, pa3);
      pv_d0(o, vb0 + bo + 16384, pa0, pa1, pa2, pa3);
    }
    __syncthreads();
  }
#undef NA_WRITE
#undef NA_LOAD
  if (hi == 0) li_l[r32] = l_reg; asm volatile("s_waitcnt lgkmcnt(0)" ::: "memory");
  bf16_t* Mw = MIX + (size_t)(row0 + wid * 32) * DM + 1024 + h * 128 + r32;
#pragma unroll
  for (int r = 0; r < 16; ++r) { const int orow = crow(r, hi); const float rl = __builtin_amdgcn_rcpf(li_l[orow]);
#pragma unroll
    for (int d0 = 0; d0 < 4; ++d0) { const unsigned pk = cvtpk(o[d0][r] * rl, 0.f); Mw[(size_t)orow * DM + d0 * 32] = (bf16_t)(pk & 0xffffu); } }
  __syncthreads();
}
}

#define XB_TMO      128
#define XB_XCNT(j)  (256  + 64 * (j))
#define XB_XSUB(j)  (1280 + 64 * (j))
#define XB_XGEN(j)  (2304 + 64 * (j))
#define XB_TOP      3328
#define XB_TOPGEN   3392
#define XCD_BAR_WORDS 3456
#define XB_SPIN_CAP (1u << 22)
__device__ __forceinline__ unsigned xb_ld(unsigned* p)              { return __hip_atomic_load(p, __ATOMIC_RELAXED, __HIP_MEMORY_SCOPE_AGENT); }
__device__ __forceinline__ unsigned xb_add(unsigned* p, unsigned v) { return __hip_atomic_fetch_add(p, v, __ATOMIC_RELAXED, __HIP_MEMORY_SCOPE_AGENT); }
__device__ __forceinline__ unsigned xb_xcc_id() { return (unsigned)__builtin_amdgcn_s_getreg((3 << 11) | 20) & 0xFu; }
#define XB_SPIN(cond, bar) do { unsigned _sp = 0; while (cond) { __builtin_amdgcn_s_sleep(1); \
    if ((++_sp & 255u) == 0u) { if (xb_ld(&(bar)[XB_TMO])) break; if (_sp > XB_SPIN_CAP) { atomicAdd(&(bar)[XB_TMO], 1u); break; } } } } while (0)
struct XcdBarrier { unsigned* bar; unsigned x; volatile LAS unsigned* st; };
__device__ __forceinline__ XcdBarrier xcd_barrier_post(unsigned* bar, volatile LAS unsigned* st) {
    XcdBarrier b; b.bar = bar; b.x = xb_xcc_id(); b.st = st;
    if (threadIdx.x == 0) (void)xb_add(&bar[XB_XCNT(b.x)], 1u);
    return b;
}
__device__ __forceinline__ void xcd_barrier_complete(unsigned* bar, unsigned x, unsigned& nloc, unsigned& nx) {
    const unsigned G = gridDim.x * gridDim.y * gridDim.z;
    unsigned sum, cnt, mine, sp = 0u;
    for (;;) {
        sum = 0u; cnt = 0u; mine = 0u;
#pragma unroll
        for (unsigned j = 0; j < 16; ++j) { const unsigned c = xb_ld(&bar[XB_XCNT(j)]); sum += c; cnt += (c > 0u) ? 1u : 0u; mine = (j == x) ? c : mine; }
        if (sum == G) break;
        __builtin_amdgcn_s_sleep(1);
        if ((++sp & 255u) == 0u) { if (xb_ld(&bar[XB_TMO])) break; if (sp > XB_SPIN_CAP) { atomicAdd(&bar[XB_TMO], 1u); break; } }
    }
    nloc = mine > 0u ? mine : 1u; nx = cnt > 0u ? cnt : 1u;
}
__device__ __forceinline__ void xcd_barrier(const XcdBarrier& b) {
    asm volatile("s_waitcnt vmcnt(0)" ::: "memory");
    __syncthreads();
    if (threadIdx.x == 0) {
        unsigned* bar = b.bar;
        __builtin_amdgcn_s_waitcnt(0);
        unsigned nloc = b.st[0], nx = b.st[1];
        if (nloc == 0u) { xcd_barrier_complete(bar, b.x, nloc, nx); b.st[0] = nloc; b.st[1] = nx; }
        const unsigned old = xb_add(&bar[XB_XSUB(b.x)], 1u);
        const unsigned gen = old / nloc;
        if (old + 1u == (gen + 1u) * nloc) {
            __builtin_amdgcn_fence(__ATOMIC_RELEASE, "agent");
            asm volatile("s_waitcnt vmcnt(0)" ::: "memory");
            const unsigned og = xb_add(&bar[XB_TOP], 1u);
            const unsigned tg = og / nx;
            if (og + 1u == (tg + 1u) * nx) xb_add(&bar[XB_TOPGEN], 1u);
            else XB_SPIN(xb_ld(&bar[XB_TOPGEN]) == tg, bar);
            __builtin_amdgcn_fence(__ATOMIC_ACQUIRE, "agent");
            xb_add(&bar[XB_XGEN(b.x)], 1u);
            asm volatile("s_waitcnt vmcnt(0)" ::: "memory");
        } else {
            XB_SPIN(xb_ld(&bar[XB_XGEN(b.x)]) == gen, bar);
            __builtin_amdgcn_fence(__ATOMIC_ACQUIRE, "agent");
            asm volatile("s_waitcnt vmcnt(0)" ::: "memory");
        }
    }
    __syncthreads();
}

struct Frame {
    LAS unsigned char* lds; char* ldsg;
    int wave, vcu, G, gw, NGW;
};

template <int MODE>
__device__ __forceinline__ void transpose_item(const float* __restrict__ W, int K, int N, bf16_t* __restrict__ WT, LAS float* scr, int item, int lane) {
    const int nblk = N / 32, kb = item / nblk, nb = item % nblk, k0 = 64 * kb, n0 = 32 * nb;
#pragma unroll 8
    for (int i = 0; i < 32; ++i) { const int kk = 2 * i + (lane >> 5); scr[kk * 33 + (lane & 31)] = W[(size_t)(k0 + kk) * N + n0 + (lane & 31)]; }
    LDS_WAIT(); asm volatile("" ::: "memory");
    int d0;
    if (MODE == 1) { const int half = n0 >= DFF ? 1 : 0, j0 = n0 - half * DFF; d0 = (j0 >> 7) * 256 + half * 128 + (j0 & 127); } else d0 = n0;
    const int c = lane & 7;
#pragma unroll
    for (int j = 0; j < 4; ++j) { const int n = (lane >> 3) + 8 * j; const LAS float* s = scr + (8 * c) * 33 + n;
        u32x4 o; o.x = cvt_pk_bf16(s[0 * 33], s[1 * 33]); o.y = cvt_pk_bf16(s[2 * 33], s[3 * 33]); o.z = cvt_pk_bf16(s[4 * 33], s[5 * 33]); o.w = cvt_pk_bf16(s[6 * 33], s[7 * 33]);
        *(u32x4*)(WT + (size_t)(d0 + n) * K + k0 + 8 * c) = o; }
    LDS_WAIT(); asm volatile("" ::: "memory");
}

struct Args { const float* in[31]; float* out; unsigned char* ws; int ph_lo, ph_hi, li, pad; };
enum { I_X = 0, I_C, I_CTX, I_CCTX, I_ADAW, I_ADAB, I_N1W, I_N2W, I_W13, I_W2, I_EWIN, I_EWOUT, I_LQ1, I_LK1, I_LQ2, I_LK2, I_SUBLN, I_RPB,
       I_OWIN, I_OWOUT, I_LAMRE, I_LAMIM, I_BRE, I_BIM, I_CRE, I_CIM, I_LOGSTEP, I_S5D, I_WGLU, I_DECAY, I_FNW };
#ifndef PRO_ROUNDS
#define PRO_ROUNDS 25
#endif
constexpr int PH_PER_LAYER = 10, P_FINAL = 1 + 4 * PH_PER_LAYER, NPHASE = P_FINAL + 1;

typedef __attribute__((address_space(4))) const unsigned char* kaptr_t;
__device__ __forceinline__ const float* ldin(int i) {
    kaptr_t ka = (kaptr_t)__builtin_amdgcn_kernarg_segment_ptr();
    unsigned off = (unsigned)i * 8u; asm volatile("" : "+s"(off));
    const unsigned long long pv = *(const unsigned long long __attribute__((address_space(4)))*)(ka + off);
    return (const float*)(const GAS float*)pv;
}
__global__ void __launch_bounds__(512, 2) fwd(Args args) {
    extern __shared__ __attribute__((aligned(16))) unsigned char lds_raw[];
    Frame F;
    F.lds = (LAS unsigned char*)lds_raw; F.ldsg = (char*)lds_raw;
    F.wave = __builtin_amdgcn_readfirstlane((int)threadIdx.x >> 6);
    F.G = gridDim.x; { const int bx = blockIdx.x; F.vcu = (F.G % 8 == 0) ? (bx % 8) * (F.G / 8) + bx / 8 : bx; }
    F.gw = F.vcu * 8 + F.wave; F.NGW = F.G * 8;
    unsigned char* ws = (unsigned char*)ldin(32);
    unsigned* ctl = (unsigned*)(ws + WS_CTL);
    for (int u = threadIdx.x; u < (LDS_BYTES - LDSCTL_OFF) / 4; u += 512) ((LAS unsigned*)(F.lds + LDSCTL_OFF))[u] = 0u;
    __syncthreads();
    const int lo = args.ph_lo, hi = args.ph_hi;
    volatile LAS unsigned* MISC = (volatile LAS unsigned*)(F.lds + MISC_OFF);
    XcdBarrier bar; bar.bar = ctl + CW_BAR + args.li * BAR_STRIDE; bar.x = 0; bar.st = nullptr;
    if (hi - lo > 1) bar = xcd_barrier_post(ctl + CW_BAR + args.li * BAR_STRIDE, MISC + 8);
#define IN(k) (lo <= (k) && (k) < hi)
#define SEAM(k) do { if (IN(k) && IN((k) + 1)) xcd_barrier(bar); } while (0)

#define MOD ((float*)(wsp + WS_MOD))
#define ROPE ((float*)(wsp + WS_ROPE))
#define LAMV ((float*)(wsp + WS_LAM))
#define XW ((h16*)(wsp + WS_XW))
#define Hb ((bf16_t*)(wsp + WS_H))
#define PROJ ((bf16_t*)(wsp + WS_PROJ))
#define ACT ((bf16_t*)(wsp + WS_PROJ))
#define MIX ((bf16_t*)(wsp + WS_MIX))
#define Ub ((float*)(wsp + WS_U))
#define Y2 ((float*)(wsp + WS_Y2))
#define ORb ((float*)(wsp + WS_OR))
#define O1 ((float*)(wsp + WS_O1))
#define KVb ((h16*)(wsp + WS_OR))
#define SINb ((bf16_t*)(wsp + WS_OR + 100 * MiB))
#define UCb ((bf16_t*)(wsp + WS_UC))
#define A2b ((bf16_t*)(wsp + WS_A2))
#define Eb ((float*)(wsp + WS_E))
#define YGb ((bf16_t*)(wsp + WS_YG))
#define W1Tb ((bf16_t*)(wsp + WS_W1T))
#define W2Tb ((bf16_t*)(wsp + WS_W2T))
#define WGTb ((bf16_t*)(wsp + WS_WGT))
#define SLAB ((float*)(wsp + WS_O1))
#define modL (MOD + (size_t)(L * 2) * 12288)
#define PH_BEGIN unsigned long long wsi_ = (unsigned long long)ws; asm volatile("" : "+s"(wsi_)); unsigned char* wsp = (unsigned char*)(GAS unsigned char*)wsi_; \
    int pG = F.G, pvcu = F.vcu, pwave = F.wave; asm volatile("" : "+s"(pG), "+s"(pvcu), "+s"(pwave)); const int pgw = pvcu * 8 + pwave, pNGW = pG * 8; (void)pgw; (void)pNGW; \
    const int plane = lane_now(); const int ptid = pwave * 64 + plane; (void)ptid;

    if (IN(0)) { PH_BEGIN
        {
            const float* cv = ldin(I_C); const float* ccv = ldin(I_CCTX);
            LAS f32x4* red = (LAS f32x4*)F.lds;
            const int jc = ptid & 31, kq = ptid >> 5;
            for (int it = blockIdx.x; it < 4 * 96; it += pG) {
                const int L = it / 96, slab = it % 96;
                const float* W = ldin(I_ADAW) + (size_t)L * DM * 12288 + slab * 128 + 4 * jc;
                f32x4 a0 = {0.f, 0.f, 0.f, 0.f}, a1 = {0.f, 0.f, 0.f, 0.f};
#pragma unroll 8
                for (int k = kq; k < DM; k += 16) { const f32x4 w = *(const f32x4*)(W + (size_t)k * 12288); const float s0 = silu_f(cv[k]), s1 = silu_f(ccv[k]); a0 = a0 + w * s0; a1 = a1 + w * s1; }
                red[(0 * 16 + kq) * 32 + jc] = a0; red[(1 * 16 + kq) * 32 + jc] = a1;
                __syncthreads();
                if (ptid < 64) { const int which = ptid >> 5; f32x4 s = {0.f, 0.f, 0.f, 0.f};
#pragma unroll
                    for (int q = 0; q < 16; ++q) s = s + red[(which * 16 + q) * 32 + jc];
                    const f32x4 b = *(const f32x4*)(ldin(I_ADAB) + (size_t)L * 12288 + slab * 128 + 4 * jc);
                    *(f32x4*)(MOD + (size_t)(L * 2 + which) * 12288 + slab * 128 + 4 * jc) = s + b; }
                __syncthreads();
            }
        }
        {
            LAS float* k0 = (LAS float*)F.lds;
            const int b2 = ((int)blockIdx.x + pG - (128 % pG)) % pG;
            for (int it = b2; it < 64; it += pG) {
                const int jl2 = it >> 5, g = it & 31;
                {
                    const int dir = ptid >> 8, cp = (ptid >> 4) & 15, c = ptid & 15;
                    const int pg = (jl2 * 2 + dir) * 32 + g;
                    const float dt = expf(ldin(I_LOGSTEP)[pg]);
                    const float* lre = ldin(I_LAMRE) + pg * 64; const float* lim = ldin(I_LAMIM) + pg * 64;
                    const float* bre = ldin(I_BRE) + (size_t)pg * 64 * 16 + c; const float* bim = ldin(I_BIM) + (size_t)pg * 64 * 16 + c;
                    const float* cre = ldin(I_CRE) + (size_t)(pg * 16 + cp) * 64; const float* cim = ldin(I_CIM) + (size_t)(pg * 16 + cp) * 64;
                    float Kt[16];
#pragma unroll
                    for (int q = 0; q < 16; ++q) Kt[q] = 0.f;
                    for (int p = 0; p < 64; ++p) {
                        const float lr = lre[p], li = lim[p];
                        const float mag = expf(lr * dt); float sn, cs; sincosf(li * dt, &sn, &cs);
                        const float ar = mag * cs, ai = mag * sn, den = lr * lr + li * li, nr = ar - 1.f, ni = ai;
                        const float fr = (nr * lr + ni * li) / den, fi = (ni * lr - nr * li) / den;
                        const float br = bre[p * 16], bi = bim[p * 16];
                        const float bbr = fr * br - fi * bi, bbi = fr * bi + fi * br;
                        const float cr = cre[p], ci = cim[p];
                        const float zr = cr * bbr - ci * bbi, zi = cr * bbi + ci * bbr;
                        float wr_ = 1.f, wi_ = 0.f;
#pragma unroll
                        for (int q = 0; q < 16; ++q) { Kt[q] += zr * wr_ - zi * wi_; const float t2 = wr_ * ar - wi_ * ai; wi_ = wr_ * ai + wi_ * ar; wr_ = t2; }
                    }
                    k0[(dir * 16 + cp) * 16 + c] = Kt[0];
                    __syncthreads();
                    bf16_t* W2 = W2Tb + (size_t)((jl2 * 32 + g) * 256) * 512;
                    if (dir == 0) {
#pragma unroll
                        for (int q = 1; q < 16; ++q) { const bf16_t kv = (bf16_t)(cvt_pk_bf16(Kt[q], 0.f) & 0xffffu);
                            for (int sq = 0; sq + q < 16; ++sq) W2[(size_t)((sq + q) * 16 + cp) * 512 + sq * 16 + c] = kv; }
                        const float dd = (c == cp) ? ldin(I_S5D)[jl2 * 512 + g * 16 + c] : 0.f;
                        const bf16_t kd = (bf16_t)(cvt_pk_bf16(Kt[0] + k0[(16 + cp) * 16 + c] + dd, 0.f) & 0xffffu);
                        for (int t = 0; t < 16; ++t) W2[(size_t)(t * 16 + cp) * 512 + t * 16 + c] = kd;
                    } else {
#pragma unroll
                        for (int q = 1; q < 16; ++q) { const bf16_t kv = (bf16_t)(cvt_pk_bf16(Kt[q], 0.f) & 0xffffu);
                            for (int t = 0; t + q < 16; ++t) W2[(size_t)(t * 16 + cp) * 512 + (t + q) * 16 + c] = kv; }
                    }
                }
                {
                    const int tq = ptid >> 7, dir = (ptid >> 6) & 1, p = ptid & 63;
                    const int pg = (jl2 * 2 + dir) * 32 + g;
                    const float dt = expf(ldin(I_LOGSTEP)[pg]);
                    const float lr = ldin(I_LAMRE)[pg * 64 + p], li = ldin(I_LAMIM)[pg * 64 + p];
                    const float mag = expf(lr * dt); float sn, cs; sincosf(li * dt, &sn, &cs);
                    const float ar = mag * cs, ai = mag * sn, den = lr * lr + li * li, nr = ar - 1.f, ni = ai;
                    const float fr = (nr * lr + ni * li) / den, fi = (ni * lr - nr * li) / den;
                    float pr[17], pi[17]; pr[0] = 1.f; pi[0] = 0.f;
#pragma unroll
                    for (int q = 1; q < 17; ++q) { pr[q] = pr[q - 1] * ar - pi[q - 1] * ai; pi[q] = pr[q - 1] * ai + pi[q - 1] * ar; }
                    bf16_t* W1r = W1Tb + (size_t)((jl2 * 32 + g) * 256 + dir * 128 + 2 * p) * 256;
                    const float* bre = ldin(I_BRE) + (size_t)(pg * 64 + p) * 16; const float* bim = ldin(I_BIM) + (size_t)(pg * 64 + p) * 16;
                    float bbr[16], bbi[16];
#pragma unroll
                    for (int c = 0; c < 16; ++c) { const float br = bre[c], bi = bim[c]; bbr[c] = fr * br - fi * bi; bbi[c] = fr * bi + fi * br; }
#pragma unroll 1
                    for (int t4 = 0; t4 < 4; ++t4) {
                        float per = 0.f, pei = 0.f;
#pragma unroll
                        for (int tt = 0; tt < 16; ++tt) { if (tt == 4 * tq + t4) { per = dir ? pr[tt] : pr[15 - tt]; pei = dir ? pi[tt] : pi[15 - tt]; } }
                        const int t = 4 * tq + t4;
#pragma unroll
                        for (int c8 = 0; c8 < 2; ++c8) { u32x4 vre, vim;
#define S5W1(c_, re_) ((re_) ? (per * bbr[c_] - pei * bbi[c_]) : (per * bbi[c_] + pei * bbr[c_]))
                            vre.x = cvt_pk_bf16(S5W1(8 * c8 + 0, 1), S5W1(8 * c8 + 1, 1)); vre.y = cvt_pk_bf16(S5W1(8 * c8 + 2, 1), S5W1(8 * c8 + 3, 1));
                            vre.z = cvt_pk_bf16(S5W1(8 * c8 + 4, 1), S5W1(8 * c8 + 5, 1)); vre.w = cvt_pk_bf16(S5W1(8 * c8 + 6, 1), S5W1(8 * c8 + 7, 1));
                            vim.x = cvt_pk_bf16(S5W1(8 * c8 + 0, 0), S5W1(8 * c8 + 1, 0)); vim.y = cvt_pk_bf16(S5W1(8 * c8 + 2, 0), S5W1(8 * c8 + 3, 0));
                            vim.z = cvt_pk_bf16(S5W1(8 * c8 + 4, 0), S5W1(8 * c8 + 5, 0)); vim.w = cvt_pk_bf16(S5W1(8 * c8 + 6, 0), S5W1(8 * c8 + 7, 0));
#undef S5W1
                            *(u32x4*)(W1r + t * 16 + 8 * c8) = vre; *(u32x4*)(W1r + 256 + t * 16 + 8 * c8) = vim; }
                    }
                    bf16_t* W2 = W2Tb + (size_t)((jl2 * 32 + g) * 256) * 512 + 256 + dir * 128 + 2 * p;
                    const float* cre = ldin(I_CRE) + (size_t)(pg * 16) * 64 + p; const float* cim = ldin(I_CIM) + (size_t)(pg * 16) * 64 + p;
#pragma unroll 1
                    for (int t4 = 0; t4 < 4; ++t4) {
                        float per = 0.f, pei = 0.f;
#pragma unroll
                        for (int tt = 0; tt < 16; ++tt) { if (tt == 4 * tq + t4) { per = dir ? pr[16 - tt] : pr[tt + 1]; pei = dir ? pi[16 - tt] : pi[tt + 1]; } }
                        const int t = 4 * tq + t4;
#pragma unroll
                        for (int cp = 0; cp < 16; ++cp) { const float cr = cre[cp * 64], ci = cim[cp * 64]; const float zr = cr * per - ci * pei, zi = cr * pei + ci * per;
                            *(unsigned*)(W2 + (size_t)(t * 16 + cp) * 512) = cvt_pk_bf16(zr, -zi); }
                    }
                }
                __syncthreads();
            }
        }
        {
            LAS float* scr = (LAS float*)(F.lds + pwave * 16384);
            constexpr int IT_IN_E = 32 * (NIN_E / 32), IT_IN_O = 32 * (NIN_O / 32), IT_OUT = 32 * 64, IT_13 = 32 * (2 * DFF / 32), IT_2 = (DFF / 64) * 64;
            constexpr int IT_LAYER_E = IT_IN_E + IT_OUT + IT_13 + IT_2, IT_LAYER_O = IT_IN_O + IT_OUT + IT_13 + IT_2;
            constexpr int IT_TR = 2 * IT_LAYER_E + 2 * IT_LAYER_O;
            constexpr int IT_ROPE = 64, IT_XW = NCTX, IT_LAM = 1, IT_WG = 2 * 128;
            constexpr int IT_ALL = IT_TR + IT_ROPE + IT_XW + IT_LAM + IT_WG;
            const int nstat = min(IT_ALL, PRO_ROUNDS * pNGW);
            const int nx = (pG % 8 == 0) ? 8 : 1, xq = (nx == 8) ? ((int)blockIdx.x & 7) : 0;
            unsigned* qctr = ctl + CW_DQ + 64 + xq * 32;
            int sit = pgw, d0 = 0, dleft = 0; unsigned jpend = 0u;
            for (;;) {
                int it;
                if (sit < nstat) { it = sit; sit += pNGW; if (sit >= nstat && plane == 0) jpend = __hip_atomic_fetch_add(qctr, 1u, __ATOMIC_RELAXED, __HIP_MEMORY_SCOPE_AGENT); }
                else {
                    if (dleft == 0) { const unsigned jq = (unsigned)__builtin_amdgcn_readfirstlane((int)jpend); d0 = nstat + (int)(jq * (unsigned)nx + (unsigned)xq) * 2; if (d0 >= IT_ALL) break; dleft = 2;
                        if (plane == 0) jpend = __hip_atomic_fetch_add(qctr, 1u, __ATOMIC_RELAXED, __HIP_MEMORY_SCOPE_AGENT); }
                    it = d0 + (2 - dleft); --dleft; if (it >= IT_ALL) continue;
                }
                int r = it;
                if (r < IT_TR) {
                    const int pair = r / (IT_LAYER_E + IT_LAYER_O); r -= pair * (IT_LAYER_E + IT_LAYER_O);
                    int L, odd; if (r < IT_LAYER_E) { L = 2 * pair; odd = 0; } else { L = 2 * pair + 1; odd = 1; r -= IT_LAYER_E; }
                    const int itin = odd ? IT_IN_O : IT_IN_E, nin = odd ? NIN_O : NIN_E;
                    if (r < itin) { const float* W = odd ? ldin(I_OWIN) + (size_t)pair * DM * NIN_O : ldin(I_EWIN) + (size_t)pair * DM * NIN_E;
                        transpose_item<0>(W, DM, nin, (bf16_t*)(ws + WS_WIN + (size_t)L * 26 * MiB), scr, r, plane); continue; } r -= itin;
                    if (r < IT_OUT) { const float* W = (odd ? ldin(I_OWOUT) : ldin(I_EWOUT)) + (size_t)pair * DM * DM;
                        transpose_item<0>(W, DM, DM, (bf16_t*)(ws + WS_WOUT + (size_t)L * 8 * MiB), scr, r, plane); continue; } r -= IT_OUT;
                    if (r < IT_13) { transpose_item<1>(ldin(I_W13) + (size_t)L * DM * 2 * DFF, DM, 2 * DFF, (bf16_t*)(ws + WS_W13 + (size_t)L * 44 * MiB), scr, r, plane); continue; } r -= IT_13;
                    transpose_item<0>(ldin(I_W2) + (size_t)L * DFF * DM, DFF, DM, (bf16_t*)(ws + WS_W2 + (size_t)L * 22 * MiB), scr, r, plane); continue;
                }
                r -= IT_TR;
                if (r < IT_ROPE) { const int idx = r * 64 + plane, pos = idx >> 4, f = idx & 15;
                    const float freq = powf(10000.f, -(float)f / 16.f); const float ang = (float)pos * freq; float sn, cs; sincosf(ang, &sn, &cs);
                    ROPE[idx * 2] = cs; ROPE[idx * 2 + 1] = sn; continue; }
                r -= IT_ROPE;
                if (r < IT_XW) { const float* src = ldin(I_CTX) + (size_t)r * DM;
#pragma unroll
                    for (int j = 0; j < 4; ++j) { const int c = 8 * (plane + 64 * j); st8h(XW + (size_t)r * DM + c, *(const f32x4*)(src + c), *(const f32x4*)(src + c + 4)); }
                    continue; }
                r -= IT_XW;
                if (r >= IT_LAM) { r -= IT_LAM; const int j2 = r >> 7; transpose_item<0>(ldin(I_WGLU) + (size_t)j2 * 512 * 512, 512, 512, WGTb + (size_t)j2 * 512 * 512, scr, r & 127, plane); continue; }
                {
                    for (int je = 0; je < 2; ++je) {
                        const float a = wave_sum(ldin(I_LQ1)[je * 64 + plane] * ldin(I_LK1)[je * 64 + plane]);
                        const float b = wave_sum(ldin(I_LQ2)[je * 64 + plane] * ldin(I_LK2)[je * 64 + plane]);
                        const float li = 0.8f - 0.6f * expf(-0.3f * (float)(2 * je));
                        if (plane == 0) { LAMV[je * 2] = expf(a) - expf(b) + li; LAMV[je * 2 + 1] = 1.f - li; }
                    }
                }
            }
        }
    }
    SEAM(0);

    for (int L = 0; L < 4; ++L) {
        const int pb = 1 + L * PH_PER_LAYER;
        const bool odd = (L & 1) != 0; const int jl = L >> 1;
#define NORM_LOAD(F32_, n_, r_) do { const int nl_ = min((n_), NT - 1); \
            if (F32_) { const float* p_ = xin + (size_t)(nl_ - NCTX) * DM + 8 * plane; _Pragma("unroll") for (int j = 0; j < 4; ++j) { r_[2 * j] = *(const u32x4*)(p_ + 512 * j); r_[2 * j + 1] = *(const u32x4*)(p_ + 512 * j + 4); } } \
            else { const h16* p_ = XW + (size_t)nl_ * DM + 8 * plane; _Pragma("unroll") for (int j = 0; j < 4; ++j) r_[j] = *(const u32x4*)(p_ + 512 * j); } } while (0)
#define NORM_CVT(F32_, r_, v_) do { if (F32_) { _Pragma("unroll") for (int j = 0; j < 8; ++j) v_[j] = __builtin_bit_cast(f32x4, r_[(F32_) ? j : 0]); } \
            else { _Pragma("unroll") for (int j = 0; j < 4; ++j) { const f32x8 f_ = __builtin_convertvector(__builtin_bit_cast(h16x8, r_[j]), f32x8); v_[2 * j] = (f32x4){f_[0], f_[1], f_[2], f_[3]}; v_[2 * j + 1] = (f32x4){f_[4], f_[5], f_[6], f_[7]}; } } } while (0)
#define NORM_LATENT(which, F32_) do { int n = NCTX + pgw; \
              u32x4 r1[(F32_) ? 8 : 4], r2[(F32_) ? 8 : 4]; \
              NORM_LOAD(F32_, n, r1); NORM_LOAD(F32_, n + pNGW, r2); \
              while (n < NT) { \
                f32x4 v[8]; NORM_CVT(F32_, r1, v); \
                _Pragma("unroll") for (int j = 0; j < ((F32_) ? 8 : 4); ++j) r1[j] = r2[j]; \
                NORM_LOAD(F32_, n + 2 * pNGW, r2); \
                unsigned long long mvi_ = (unsigned long long)(modL), nwi_ = (unsigned long long)nw; asm volatile("" : "+s"(mvi_), "+s"(nwi_)); const float* mv = (const float*)(const GAS float*)mvi_; const float* nwl = (const float*)(const GAS float*)nwi_; const float* shp = mv + ((which) ? 3 : 0) * DM; const float* scp = mv + ((which) ? 4 : 1) * DM; \
                float ss = 0.f; \
                _Pragma("unroll") for (int j = 0; j < 8; ++j) ss += (v[j].x * v[j].x + v[j].y * v[j].y) + (v[j].z * v[j].z + v[j].w * v[j].w); \
                const float rstd = rsqrtf(wave_sum(ss) * (1.f / DM) + EPS); \
                _Pragma("unroll") for (int j = 0; j < 4; ++j) { const int col = 8 * plane + 512 * j; u32x4 pk; \
                    { const f32x4 w4 = *(const f32x4*)(nwl + col), s4 = *(const f32x4*)(scp + col), h4 = *(const f32x4*)(shp + col); const f32x4 y = v[2 * j] * rstd * w4 * (s4 + 1.f) + h4; pk.x = cvt_pk_bf16(y.x, y.y); pk.y = cvt_pk_bf16(y.z, y.w); } \
                    { const f32x4 w4 = *(const f32x4*)(nwl + col + 4), s4 = *(const f32x4*)(scp + col + 4), h4 = *(const f32x4*)(shp + col + 4); const f32x4 y = v[2 * j + 1] * rstd * w4 * (s4 + 1.f) + h4; pk.z = cvt_pk_bf16(y.x, y.y); pk.w = cvt_pk_bf16(y.z, y.w); } \
                    *(u32x4*)(Hb + (size_t)n * DM + col) = pk; } \
                n += pNGW; \
              } } while (0)
#define NORM_PHASE(which) do { PH_BEGIN \
            const float* nw = ldin((which) ? I_N2W : I_N1W) + (size_t)L * DM; \
            const float* xin = (!(which) && L == 0) ? ldin(I_X) : nullptr;              \
              \
            if (!((which) && L == 3)) { \
                const int nparts = (which) ? 8 : (L > 0 ? 11 : 0); \
                volatile LAS float* red = (volatile LAS float*)F.lds; \
                for (int r = pvcu; r < NCTX; r += pG) { \
                    const int col = 4 * ptid; \
                    const h16x4 hx = *(const h16x4*)(XW + (size_t)r * DM + col); \
                    f32x4 a = __builtin_convertvector(hx, f32x4); \
                    if (nparts > 0) { f32x4 s[11]; const float* sp = SLAB + (size_t)r * DM + col; \
                        _Pragma("unroll") for (int pp = 0; pp < 8; ++pp) s[pp] = *(const f32x4*)(sp + (size_t)pp * NCTX * DM); \
                        _Pragma("unroll") for (int pp = 8; pp < 11; ++pp) s[pp] = *(const f32x4*)(sp + (size_t)(nparts > 8 ? pp : 0) * NCTX * DM); \
                        _Pragma("unroll") for (int pp = 0; pp < 8; ++pp) a = a + s[pp]; \
                        if (nparts > 8) a = a + ((s[8] + s[9]) + s[10]); \
                        *(h16x4*)(XW + (size_t)r * DM + col) = __builtin_convertvector(a, h16x4); } \
                    const float ps = wave_sum((a.x * a.x + a.y * a.y) + (a.z * a.z + a.w * a.w)); \
                    if (plane == 0) red[pwave] = ps; \
                    const float* mv = modL + 12288; const float* shp = mv + ((which) ? 3 : 0) * DM; const float* scp = mv + ((which) ? 4 : 1) * DM; \
                    const f32x4 w4 = *(const f32x4*)(nw + col), s4 = *(const f32x4*)(scp + col), h4 = *(const f32x4*)(shp + col); \
                    __syncthreads(); \
                    const float tot = ((red[0] + red[1]) + (red[2] + red[3])) + ((red[4] + red[5]) + (red[6] + red[7])); \
                    const float rstd = rsqrtf(tot * (1.f / DM) + EPS); \
                    const f32x4 y = a * rstd * w4 * (s4 + 1.f) + h4; \
                    u32x2 pk; pk.x = cvt_pk_bf16(y.x, y.y); pk.y = cvt_pk_bf16(y.z, y.w); \
                    *(u32x2*)(Hb + (size_t)r * DM + col) = pk; \
                    __syncthreads(); \
                } } \
              \
            if (xin != nullptr) NORM_LATENT(which, 1); else NORM_LATENT(which, 0); } while (0)

        if (IN(pb + 0)) { NORM_PHASE(0); }
        SEAM(pb + 0);

        if (IN(pb + 1)) { PH_BEGIN
            if (!odd) {
                pg8::Gemm g{Hb, (const bf16_t*)(ws + WS_WIN + (size_t)L * 26 * MiB), NT, NIN_E, DM, DM, DM};
                pg8::StaticOrder S; S.init(NT / 256, NIN_E / 256, pG, (int)blockIdx.x, 0);
                pg8::EpiEvenIn E{PROJ, ROPE, ctl + CW_KM + jl * 32};
                pg8::gemm_phase<pg8::EpiEvenIn, pg8::StaticOrder, true, true>(F.lds, g, S, E, pwave);

            } else {
                pg8::Gemm g{Hb, (const bf16_t*)(ws + WS_WIN + (size_t)L * 26 * MiB), NT, NIN_O, DM, DM, DM};
                pg8::StaticOrder S; S.init(NT / 256, NIN_O / 256, pG, (int)blockIdx.x, 0);
                pg8::EpiOddIn2 E{PROJ, UCb, A2b};
                pg8::gemm_phase<pg8::EpiOddIn2, pg8::StaticOrder, true, true>(F.lds, g, S, E, pwave);

            }
        }
        SEAM(pb + 1);

        {
        if (IN(pb + 2)) { PH_BEGIN
            if (!odd) {
                const float lam = LAMV[jl * 2], omli = LAMV[jl * 2 + 1];
                const float* subln = ldin(I_SUBLN) + jl * 128;
                for (int ui = pvcu; ui < 520; ui += pG) {
                    int h, row0, seq;
                    if (ui < 512) { h = ui >> 6; row0 = NCTX + (ui & 63) * 256; seq = NT; } else { h = ui - 512; row0 = 0; seq = NCTX; }
                    const float* kmp = (const float*)(ctl + CW_KM) + (jl * 8 + h) * 4;
                    da::diff_unit(PROJ, h, row0, seq, kmp[0] + kmp[1], kmp[2] + kmp[3], lam, omli, subln, O1, MIX, F.ldsg, pwave);
                }
                for (;;) {
                    __syncthreads();
                    if (ptid == 0) MISC[2] = __hip_atomic_fetch_add(ctl + CW_DQ + jl * 32, 1u, __ATOMIC_RELAXED, __HIP_MEMORY_SCOPE_AGENT);
                    __syncthreads();
                    const int ui = (int)MISC[2];
                    if (ui >= 520) break;
                    int h, qb; if (ui < 512) { h = ui >> 6; qb = ui & 63; } else { h = ui - 512; qb = -1; }
                    rt::na_unit(PROJ, h, qb, ldin(I_RPB) + (size_t)(jl * 8 + h) * 15 * 31, MIX, F.ldsg, pwave);
                }
            } else {
                {
                    pg8::Gemm g{UCb, W1Tb + (size_t)jl * 32 * 256 * 256, 32 * 1280, 256, 256, 256, 256};
                    pg8::BatchOrder S{160, pG, (int)blockIdx.x};
                    pg8::EpiS5E E{Eb};
                    pg8::gemm_phase<pg8::EpiS5E, pg8::BatchOrder, true, true>(F.lds, g, S, E, pwave);
                }
                for (int ui = (pvcu + pG - (20 % pG)) % pG; ui < 12 * rt::NCH; ui += pG) {
                    const int h = ui / rt::NCH, k = ui % rt::NCH;
                    const float lgf = -log1pf(expf(-ldin(I_DECAY)[(jl * 2 + 0) * 12 + h])) * LOG2E, lgr = -log1pf(expf(-ldin(I_DECAY)[(jl * 2 + 1) * 12 + h])) * LOG2E;
                    rt::kv_unit(PROJ, h, k, lgf, lgr, KVb, F.ldsg, pwave);
                }
            }
        }
        SEAM(pb + 2);

        if (odd && IN(pb + 3)) { PH_BEGIN
            for (int it = pvcu; it < 64; it += pG) {
                const int dir = it >> 5, g = it & 31, p = plane;
                const int pg = (jl * 2 + dir) * 32 + g;
                const float lr = ldin(I_LAMRE)[pg * 64 + p], li = ldin(I_LAMIM)[pg * 64 + p];
                const float dt = expf(ldin(I_LOGSTEP)[pg]);
                const float mag = expf(16.f * lr * dt); float sn, cs; sincosf(16.f * li * dt, &sn, &cs);
                const float ar = mag * cs, ai = mag * sn;
                const float* Eg = Eb + (size_t)(g * 1280) * 256 + dir * 128 + 2 * p; bf16_t* Hg = A2b + (size_t)(g * 1280) * 512 + 256 + dir * 128 + 2 * p;
                LAS f32x2* segT = (LAS f32x2*)F.lds;
                float hr = 0.f, hi2 = 0.f, pwr = 1.f, pwi = 0.f;
                const int s0 = 130 * pwave;
#define S5ROW(s_) (dir == 0 ? ((s_) < 16 ? (s_) : 240 + (s_)) : ((s_) < 16 ? 15 - (s_) : 1295 - (s_)))
                for (int b = 0; b < 5; ++b) {
                    f32x2 e[26];
#pragma unroll
                    for (int q = 0; q < 26; ++q) { const int s_ = s0 + b * 26 + q; e[q] = *(const f32x2*)(Eg + (size_t)S5ROW(s_) * 256); }
#pragma unroll
                    for (int q = 0; q < 26; ++q) { const float nhr = ar * hr - ai * hi2 + e[q].x, nhi = ar * hi2 + ai * hr + e[q].y; hr = nhr; hi2 = nhi;
                        const float t2 = pwr * ar - pwi * ai; pwi = pwr * ai + pwi * ar; pwr = t2; }
                }
                segT[pwave * 64 + p] = (f32x2){hr, hi2};
                __syncthreads();
                hr = 0.f; hi2 = 0.f;
                for (int v = 0; v < pwave; ++v) { const f32x2 T = segT[v * 64 + p]; const float nhr = pwr * hr - pwi * hi2 + T.x, nhi = pwr * hi2 + pwi * hr + T.y; hr = nhr; hi2 = nhi; }
                for (int b = 0; b < 5; ++b) {
                    f32x2 e[26];
#pragma unroll
                    for (int q = 0; q < 26; ++q) { const int s_ = s0 + b * 26 + q; e[q] = *(const f32x2*)(Eg + (size_t)S5ROW(s_) * 256); }
#pragma unroll
                    for (int q = 0; q < 26; ++q) { const int s_ = s0 + b * 26 + q; *(unsigned*)(Hg + (size_t)S5ROW(s_) * 512) = cvt_pk_bf16(hr, hi2);
                        const float nhr = ar * hr - ai * hi2 + e[q].x, nhi = ar * hi2 + ai * hr + e[q].y; hr = nhr; hi2 = nhi; }
                }
#undef S5ROW
                __syncthreads();
            }
            for (int idx = ((pvcu + pG - (64 % pG)) % pG) * 512 + ptid; idx < 2 * 12 * 4096; idx += pG * 512) {
                const int dir = idx / (12 * 4096), h = (idx >> 12) % 12, e = idx & 4095;
                const float lg2 = -log1pf(expf(-ldin(I_DECAY)[(jl * 2 + dir) * 12 + h])) * LOG2E;
                const float gC = __builtin_amdgcn_exp2f(lg2 * 256.f);
                const size_t base = (size_t)(dir * 12 + h) * rt::NCH * 16384 + (size_t)e * 4;
                const h16* kvp = KVb + base; bf16_t* sp = SINb + base;
                f32x4 S = {0.f, 0.f, 0.f, 0.f};
                const long stp = dir ? -16384 : 16384; const long o1 = dir ? 64 * 16384 : 16384;
#define R2OFF(i_) ((i_) == 0 ? 0L : o1 + (long)((i_) - 1) * stp)
                typedef _Float16 h16x4 __attribute__((ext_vector_type(4)));
                h16x4 kv[13];
#pragma unroll
                for (int q = 0; q < 13; ++q) kv[q] = *(const h16x4*)(kvp + R2OFF(q));
#pragma unroll
                for (int b = 0; b < 5; ++b) {
                    h16x4 nx[13];
                    if (b < 4) {
#pragma unroll
                        for (int q = 0; q < 13; ++q) nx[q] = *(const h16x4*)(kvp + R2OFF((b + 1) * 13 + q));
                    }
#pragma unroll
                    for (int q = 0; q < 13; ++q) { u32x2 pk; pk.x = cvt_pk_bf16(S.x, S.y); pk.y = cvt_pk_bf16(S.z, S.w); *(u32x2*)(sp + R2OFF(b * 13 + q)) = pk; S = S * gC + __builtin_convertvector(kv[q], f32x4); }
                    if (b < 4) {
#pragma unroll
                        for (int q = 0; q < 13; ++q) kv[q] = nx[q];
                    }
                }
#undef R2OFF
            }
        }
        if (odd) SEAM(pb + 3);

        if (odd && IN(pb + 4)) { PH_BEGIN
            {
                pg8::Gemm g{A2b, W2Tb + (size_t)jl * 32 * 256 * 512, 32 * 1280, 256, 512, 512, 512};
                pg8::BatchOrder S{160, pG, (int)blockIdx.x};
                pg8::EpiS5Y E{YGb};
                pg8::gemm_phase<pg8::EpiS5Y, pg8::BatchOrder, true, true>(F.lds, g, S, E, pwave);
            }
            for (int ui = (pvcu + pG - (20 % pG)) % pG; ui < 12 * rt::NCH; ui += pG) {
                const int h = ui / rt::NCH, k = ui % rt::NCH;
                const float lgf = -log1pf(expf(-ldin(I_DECAY)[(jl * 2 + 0) * 12 + h])) * LOG2E, lgr = -log1pf(expf(-ldin(I_DECAY)[(jl * 2 + 1) * 12 + h])) * LOG2E;
                rt::out_unit(PROJ, h, k, lgf, lgr, SINb, MIX, F.ldsg, pwave);
            }
            __syncthreads();
        }
        if (odd) SEAM(pb + 4);
        if (odd && IN(pb + 5)) { PH_BEGIN
            pg8::Gemm g{YGb, WGTb + (size_t)jl * 512 * 512, NT, 512, 512, 512, 512};
            pg8::StaticOrder S; S.init(NT / 256, 2, pG, (int)blockIdx.x, 0);
            pg8::EpiGlu E{YGb, MIX};
            pg8::gemm_phase<pg8::EpiGlu, pg8::StaticOrder, true, true>(F.lds, g, S, E, pwave);
        }
        if (odd) SEAM(pb + 5);
        }

        if (IN(pb + 6)) { PH_BEGIN
            pg8::Gemm g{MIX, (const bf16_t*)(ws + WS_WOUT + (size_t)L * 8 * MiB), NT, DM, DM, DM, DM};
            pg8::SplitOrder S; S.so.init(64, DM / 256, pG, (int)blockIdx.x, 1); S.nmini = L == 3 ? 0 : 64; S.ntp = 4;
            pg8::EpiResid E{XW, L == 0 ? ldin(I_X) : nullptr, modL + 2 * DM, modL + 12288 + 2 * DM, SLAB};
            pg8::gemm_phase<pg8::EpiResid, pg8::SplitOrder, true, true>(F.lds, g, S, E, pwave);

        }
        SEAM(pb + 6);

        if (IN(pb + 7)) { NORM_PHASE(1); }
        SEAM(pb + 7);

        if (IN(pb + 8)) { PH_BEGIN
            pg8::Gemm g{Hb, (const bf16_t*)(ws + WS_W13 + (size_t)L * 44 * MiB), NT, 2 * DFF, DM, DM, DM};
            pg8::StaticOrder S; S.init(L == 3 ? 64 : 65, 2 * DFF / 256, pG, (int)blockIdx.x, L == 3 ? 1 : 0);
            pg8::EpiSwiglu E{ACT};
            pg8::gemm_phase<pg8::EpiSwiglu, pg8::StaticOrder, true, true>(F.lds, g, S, E, pwave);

        }
        SEAM(pb + 8);

        if (IN(pb + 9)) { PH_BEGIN
            pg8::Gemm g{ACT, (const bf16_t*)(ws + WS_W2 + (size_t)L * 22 * MiB), NT, DM, DFF, DFF, DFF};
            pg8::SplitOrder S; S.so.init(64, DM / 256, pG, (int)blockIdx.x, 1); S.nmini = L == 3 ? 0 : 88; S.ntp = 8;
            pg8::EpiResid E{XW, nullptr, modL + 5 * DM, modL + 12288 + 5 * DM, SLAB};
            pg8::gemm_phase<pg8::EpiResid, pg8::SplitOrder, true, true>(F.lds, g, S, E, pwave);

        }
        SEAM(pb + 9);
    }

    if (IN(P_FINAL)) { PH_BEGIN
        const float* fw = ldin(I_FNW);
        { const float* xin = nullptr; (void)xin;
          int n = NCTX + pgw;
          u32x4 r1[4], r2[4];
          NORM_LOAD(0, n, r1); NORM_LOAD(0, n + pNGW, r2);
          while (n < NT) {
            f32x4 v[8]; float ss = 0.f;
            NORM_CVT(0, r1, v);
#pragma unroll
            for (int j = 0; j < 4; ++j) r1[j] = r2[j];
            NORM_LOAD(0, n + 2 * pNGW, r2);
#pragma unroll
            for (int j = 0; j < 8; ++j) ss += (v[j].x * v[j].x + v[j].y * v[j].y) + (v[j].z * v[j].z + v[j].w * v[j].w);
            const float rstd = rsqrtf(wave_sum(ss) * (1.f / DM) + EPS);
            float* orow = (float*)ldin(31) + (size_t)(n - NCTX) * DM + 8 * plane;
#pragma unroll
            for (int j = 0; j < 4; ++j) { const int col = 8 * plane + 512 * j;
                *(f32x4*)(orow + 512 * j) = v[2 * j] * rstd * *(const f32x4*)(fw + col); *(f32x4*)(orow + 512 * j + 4) = v[2 * j + 1] * rstd * *(const f32x4*)(fw + col + 4); }
            n += pNGW;
          } }
    }
#undef IN
#undef SEAM
#undef NORM_PHASE
#undef NORM_LOAD
#undef NORM_CVT
#undef NORM_LATENT
#undef MOD
#undef ROPE
#undef LAMV
#undef XW
#undef Hb
#undef PROJ
#undef ACT
#undef MIX
#undef Ub
#undef Y2
#undef ORb
#undef O1
#undef KVb
#undef SINb
#undef modL
#undef SLAB
#undef UCb
#undef A2b
#undef Eb
#undef YGb
#undef W1Tb
#undef W2Tb
#undef WGTb
#undef PH_BEGIN
}

#ifndef N_LAUNCH_MODE
#define N_LAUNCH_MODE 1
#endif
extern "C" void kernel_launch(void* const* d_in, const int* in_sizes, int n_in, void* d_out, int out_size, void* d_ws, size_t ws_size, hipStream_t stream) {
    static int grid = 0;
    if (grid == 0) {
        if (n_in != 31 || out_size != SEQ * DM || ws_size < WS_END) { fprintf(stderr, "kernel_launch: shape mismatch n_in %d out %d ws %zu (need %zu)\n", n_in, out_size, ws_size, (size_t)WS_END); grid = -1; return; }
        int dev = 0, cus = 0, per_cu = 0;
        if (hipGetDevice(&dev) != hipSuccess || hipDeviceGetAttribute(&cus, hipDeviceAttributeMultiprocessorCount, dev) != hipSuccess) { grid = -1; return; }
        if (hipFuncSetAttribute((const void*)fwd, hipFuncAttributeMaxDynamicSharedMemorySize, LDS_BYTES) != hipSuccess) { fprintf(stderr, "kernel_launch: hipFuncSetAttribute failed\n"); grid = -1; return; }
        if (hipOccupancyMaxActiveBlocksPerMultiprocessor(&per_cu, (const void*)fwd, 512, LDS_BYTES) != hipSuccess || per_cu < 1)
            fprintf(stderr, "kernel_launch: occupancy query reports %d blocks per CU\n", per_cu);
        (void)hipGetLastError();
        grid = cus;
    }
    if (grid < 0) return;
    if (hipMemsetAsync((char*)d_ws + WS_CTL, 0, CTL_ZERO_BYTES, stream) != hipSuccess) return;
    Args a{};
    for (int i = 0; i < 31; ++i) a.in[i] = (const float*)d_in[i];
    a.out = (float*)d_out; a.ws = (unsigned char*)d_ws; a.pad = 0;
    if (N_LAUNCH_MODE == 1) {
        a.ph_lo = 0; a.ph_hi = NPHASE; a.li = 0;
        hipLaunchKernelGGL(fwd, dim3(grid), dim3(512), LDS_BYTES, stream, a);
    } else {
        for (int p = 0; p < NPHASE; ++p) {
            const int k = p == 0 ? -1 : (p - 1) % PH_PER_LAYER; const int L = p == 0 ? -1 : (p - 1) / PH_PER_LAYER;
            if (p != 0 && p != P_FINAL && k >= 3 && k <= 5 && (L & 1) == 0) continue;
            a.ph_lo = p; a.ph_hi = p + 1; a.li = 0;
            hipLaunchKernelGGL(fwd, dim3(grid), dim3(512), LDS_BYTES, stream, a);
        }
    }
    const hipError_t le = hipPeekAtLastError();
    if (le != hipSuccess) fprintf(stderr, "kernel_launch: launch failed: %s\n", hipGetErrorName(le));
}
```
